# Optimizing an MI355X kernel written in HIP

```python
import jax, jax.numpy as jnp
from jax import lax
import numpy as np

D_MODEL = 1024
BATCH = 4
SEQ = 4096
DEPTH = 1

CHUNK = 64
Q_BLOCK = 2 * CHUNK
HEAD_DIM = 64
N_FOX_HEADS = 8
N_SB_HEADS = 8
D_FOX = N_FOX_HEADS * HEAD_DIM
D_SB = N_SB_HEADS * HEAD_DIM
D_MIX = D_FOX + D_SB
D_IN = 3 * D_FOX + 3 * D_SB + N_FOX_HEADS
N_EXPERTS = 256
TOP_K = 8
N_GROUPS = 8
TOP_GROUPS = 4
D_EXPERT = 256
D_SHARED = 256
ROUTED_SCALE = 2.5
MOE_BLOCK = 128
DEEPNORM_ALPHA = (2.0 * DEPTH) ** 0.25
DEEPNORM_BETA = (8.0 * DEPTH) ** -0.25
LN_EPS = 1e-5
RMS_EPS = 1e-6

kernel_name = "hybrid_fox_stickbreak_moe_block"


def layer_norm(x, g, b):
    xf = x.astype(jnp.float32)
    mu = jnp.mean(xf, axis=-1, keepdims=True)
    var = jnp.mean(jnp.square(xf - mu), axis=-1, keepdims=True)
    return ((xf - mu) * lax.rsqrt(var + LN_EPS) * g + b).astype(x.dtype)


def head_rms_norm(o, g):
    h = o.shape[1]
    of = o.astype(jnp.float32)
    of = of * lax.rsqrt(jnp.mean(jnp.square(of), axis=-1, keepdims=True) + RMS_EPS)
    return (of * g.reshape(h, HEAD_DIM)[None, :, None, :]).astype(o.dtype)


def forgetting_attention(q, k, v, log_f):
    seq = q.shape[2]
    scale = HEAD_DIM ** -0.5
    F = jnp.cumsum(log_f, axis=-1)
    outs = []
    for i in range(seq // Q_BLOCK):
        q0, q1 = i * Q_BLOCK, (i + 1) * Q_BLOCK
        kp, vp = k[:, :, :q1], v[:, :, :q1]
        s = jnp.einsum("bhqd,bhkd->bhqk", q[:, :, q0:q1], kp).astype(jnp.float32) * scale
        s = s + F[:, :, q0:q1, None] - F[:, :, None, :q1]
        t_idx = jnp.arange(q0, q1)[:, None]
        s_idx = jnp.arange(q1)[None, :]
        s = jnp.where(s_idx <= t_idx, s, -jnp.inf)
        p = jax.nn.softmax(s, axis=-1)
        outs.append(jnp.einsum("bhqk,bhkd->bhqd", p.astype(v.dtype), vp))
    return jnp.concatenate(outs, axis=2)


def stick_breaking_attention(q, k, v):
    seq = q.shape[2]
    scale = HEAD_DIM ** -0.5
    outs = []
    for i in range(seq // Q_BLOCK):
        q0, q1 = i * Q_BLOCK, (i + 1) * Q_BLOCK
        kp, vp = k[:, :, :q1], v[:, :, :q1]
        z = jnp.einsum("bhqd,bhkd->bhqk", q[:, :, q0:q1], kp).astype(jnp.float32) * scale
        t_idx = jnp.arange(q0, q1)[:, None]
        s_idx = jnp.arange(q1)[None, :]
        past = s_idx < t_idx
        log_beta = jax.nn.log_sigmoid(z)
        log_keep = jnp.where(past, jax.nn.log_sigmoid(-z), 0.0)
        rem = lax.cumsum(log_keep, axis=3, reverse=True) - log_keep
        a = jnp.where(past, jnp.exp(log_beta + rem), 0.0)
        outs.append(jnp.einsum("bhqk,bhkd->bhqd", a.astype(v.dtype), vp))
    return jnp.concatenate(outs, axis=2)


def mixer_sublayer(u, w_in, b_f, fox_norm_g, sb_norm_g, w_out):
    b, s, _ = u.shape
    proj = jnp.einsum("bsd,de->bse", u, w_in)
    q_f, k_f, v_f, q_s, k_s, v_s, f_logit = jnp.split(
        proj,
        [D_FOX, 2 * D_FOX, 3 * D_FOX, 3 * D_FOX + D_SB, 3 * D_FOX + 2 * D_SB, 3 * D_FOX + 3 * D_SB],
        axis=-1)

    def heads(t, h):
        return t.reshape(b, s, h, HEAD_DIM).transpose(0, 2, 1, 3)

    log_f = jax.nn.log_sigmoid((f_logit + b_f).astype(jnp.float32)).transpose(0, 2, 1)
    o_f = forgetting_attention(heads(q_f, N_FOX_HEADS), heads(k_f, N_FOX_HEADS),
                               heads(v_f, N_FOX_HEADS), log_f)
    o_s = stick_breaking_attention(heads(q_s, N_SB_HEADS), heads(k_s, N_SB_HEADS),
                                   heads(v_s, N_SB_HEADS))
    o = jnp.concatenate([head_rms_norm(o_f, fox_norm_g), head_rms_norm(o_s, sb_norm_g)], axis=1)
    o = o.transpose(0, 2, 1, 3).reshape(b, s, D_MIX)
    return jnp.einsum("bse,ed->bsd", o, w_out)


def moe_sublayer(u, w_router, router_bias, w_gate_e, w_up_e, w_down_e,
                 w_gate_sh, w_up_sh, w_down_sh):
    b, s, d = u.shape
    n = b * s
    xf = u.reshape(n, d)
    scores = jax.nn.sigmoid(jnp.einsum("nd,de->ne", xf, w_router).astype(jnp.float32))
    sel = scores + router_bias.astype(jnp.float32)
    per_group = N_EXPERTS // N_GROUPS
    grp_score = jnp.sum(lax.top_k(sel.reshape(n, N_GROUPS, per_group), 2)[0], axis=-1)
    _, top_g = lax.top_k(grp_score, TOP_GROUPS)
    g_mask = jnp.any(top_g[:, :, None] == jnp.arange(N_GROUPS)[None, None, :], axis=1)
    sel = jnp.where(jnp.repeat(g_mask, per_group, axis=1), sel, -jnp.inf)
    _, top_e = lax.top_k(sel, TOP_K)
    w = jnp.take_along_axis(scores, top_e, axis=1)
    w = w / jnp.sum(w, axis=-1, keepdims=True) * ROUTED_SCALE

    nk = n * TOP_K
    e_flat = top_e.reshape(nk)
    tok_flat = jnp.arange(nk, dtype=jnp.int32) // TOP_K
    w_flat = w.reshape(nk)
    order = jnp.argsort(e_flat)
    e_sorted, tok_sorted, w_sorted = e_flat[order], tok_flat[order], w_flat[order]
    counts = jnp.zeros((N_EXPERTS,), jnp.int32).at[e_flat].add(1)
    padded = (counts + MOE_BLOCK - 1) // MOE_BLOCK * MOE_BLOCK
    start = jnp.cumsum(counts) - counts
    pstart = jnp.cumsum(padded) - padded
    dest = pstart[e_sorted] + (jnp.arange(nk, dtype=jnp.int32) - start[e_sorted])
    n_blocks = -(-nk // MOE_BLOCK) + N_EXPERTS
    cap = n_blocks * MOE_BLOCK
    buf_tok = jnp.full((cap,), n, jnp.int32).at[dest].set(tok_sorted)
    buf_w = jnp.zeros((cap,), jnp.float32).at[dest].set(w_sorted)
    blk_start = jnp.arange(n_blocks, dtype=jnp.int32) * MOE_BLOCK
    blk_expert = jnp.clip(jnp.searchsorted(pstart + padded, blk_start, side="right"),
                          0, N_EXPERTS - 1).astype(jnp.int32)
    x_pad = jnp.concatenate([xf, jnp.zeros((1, d), xf.dtype)], axis=0)

    def expert_block(args):
        toks, wts, e = args
        xb = x_pad[toks]
        h = jax.nn.silu(xb @ w_gate_e[e]) * (xb @ w_up_e[e])
        return (h @ w_down_e[e]) * wts[:, None].astype(xb.dtype)

    y = lax.map(expert_block, (buf_tok.reshape(n_blocks, MOE_BLOCK),
                               buf_w.reshape(n_blocks, MOE_BLOCK), blk_expert))
    routed = jnp.zeros((n + 1, d), y.dtype).at[buf_tok].add(y.reshape(cap, d))[:n]
    shared = (jax.nn.silu(xf @ w_gate_sh) * (xf @ w_up_sh)) @ w_down_sh
    return (routed + shared).reshape(b, s, d)


def setup_inputs(seed: int = 0) -> dict:
    key = jax.random.key(seed)
    ks = jax.random.split(key, 22)
    nrm = jax.random.normal
    col = jnp.arange(D_IN)
    is_v = (((col >= 2 * D_FOX) & (col < 3 * D_FOX))
            | ((col >= 3 * D_FOX + 2 * D_SB) & (col < 3 * D_FOX + 3 * D_SB)))
    col_scale = jnp.where(is_v, DEEPNORM_BETA, 1.0).astype(jnp.float32)
    return {
        "x": nrm(ks[0], (BATCH, SEQ, D_MODEL), jnp.float32),
        "c": nrm(ks[1], (BATCH, D_MODEL), jnp.float32),
        "w_ada": nrm(ks[2], (DEPTH, D_MODEL, 6 * D_MODEL), jnp.float32) * (0.3 * D_MODEL ** -0.5),
        "b_ada": 0.02 * nrm(ks[3], (DEPTH, 6 * D_MODEL), jnp.float32),
        "w_in": nrm(ks[4], (DEPTH, D_MODEL, D_IN), jnp.float32) * (D_MODEL ** -0.5) * col_scale,
        "b_f": jax.random.uniform(ks[5], (DEPTH, N_FOX_HEADS), jnp.float32, 1.0, 4.0),
        "fox_norm_g": 1.0 + 0.02 * nrm(ks[6], (DEPTH, D_FOX), jnp.float32),
        "sb_norm_g": 1.0 + 0.02 * nrm(ks[7], (DEPTH, D_SB), jnp.float32),
        "w_out": nrm(ks[8], (DEPTH, D_MIX, D_MODEL), jnp.float32) * (D_MIX ** -0.5 * DEEPNORM_BETA),
        "ln1_g": 1.0 + 0.02 * nrm(ks[9], (DEPTH, D_MODEL), jnp.float32),
        "ln1_b": 0.02 * nrm(ks[10], (DEPTH, D_MODEL), jnp.float32),
        "w_router": nrm(ks[11], (DEPTH, D_MODEL, N_EXPERTS), jnp.float32) * D_MODEL ** -0.5,
        "router_bias": 0.01 * nrm(ks[12], (DEPTH, N_EXPERTS), jnp.float32),
        "w_gate_e": nrm(ks[13], (DEPTH, N_EXPERTS, D_MODEL, D_EXPERT), jnp.float32) * (D_MODEL ** -0.5 * DEEPNORM_BETA),
        "w_up_e": nrm(ks[14], (DEPTH, N_EXPERTS, D_MODEL, D_EXPERT), jnp.float32) * (D_MODEL ** -0.5 * DEEPNORM_BETA),
        "w_down_e": nrm(ks[15], (DEPTH, N_EXPERTS, D_EXPERT, D_MODEL), jnp.float32) * (D_EXPERT ** -0.5 * DEEPNORM_BETA),
        "w_gate_sh": nrm(ks[16], (DEPTH, D_MODEL, D_SHARED), jnp.float32) * (D_MODEL ** -0.5 * DEEPNORM_BETA),
        "w_up_sh": nrm(ks[17], (DEPTH, D_MODEL, D_SHARED), jnp.float32) * (D_MODEL ** -0.5 * DEEPNORM_BETA),
        "w_down_sh": nrm(ks[18], (DEPTH, D_SHARED, D_MODEL), jnp.float32) * (D_SHARED ** -0.5 * DEEPNORM_BETA),
        "ln2_g": 1.0 + 0.02 * nrm(ks[19], (DEPTH, D_MODEL), jnp.float32),
        "ln2_b": 0.02 * nrm(ks[20], (DEPTH, D_MODEL), jnp.float32),
    }


def reference(x, c, w_ada, b_ada, w_in, b_f, fox_norm_g, sb_norm_g, w_out, ln1_g, ln1_b,
              w_router, router_bias, w_gate_e, w_up_e, w_down_e,
              w_gate_sh, w_up_sh, w_down_sh, ln2_g, ln2_b):
    for l in range(DEPTH):
        ada = jnp.einsum("bd,de->be", jax.nn.silu(c), w_ada[l]) + b_ada[l]
        shift1, scale1, gate1, shift2, scale2, gate2 = [t[:, None, :] for t in jnp.split(ada, 6, axis=-1)]
        u = x * (1.0 + scale1) + shift1
        mix = mixer_sublayer(u, w_in[l], b_f[l], fox_norm_g[l], sb_norm_g[l], w_out[l])
        x = layer_norm(DEEPNORM_ALPHA * x + (1.0 + gate1) * mix, ln1_g[l], ln1_b[l])
        u = x * (1.0 + scale2) + shift2
        ffn = moe_sublayer(u, w_router[l], router_bias[l], w_gate_e[l], w_up_e[l], w_down_e[l],
                           w_gate_sh[l], w_up_sh[l], w_down_sh[l])
        x = layer_norm(DEEPNORM_ALPHA * x + (1.0 + gate2) * ffn, ln2_g[l], ln2_b[l])
    return x
```

```cpp
#define DBG_VALU_CUM 1
#include <hip/hip_runtime.h>
#include <cstdio>
#include <cstdint>

#define LAS __attribute__((address_space(3)))
#define GAS __attribute__((address_space(1)))
typedef unsigned short bf16_t;
typedef short bf16x8 __attribute__((ext_vector_type(8)));
typedef float f32x4 __attribute__((ext_vector_type(4)));
typedef float f32x16 __attribute__((ext_vector_type(16)));
typedef unsigned u32x4 __attribute__((ext_vector_type(4)));
typedef unsigned u32x2 __attribute__((ext_vector_type(2)));

constexpr int DM = 1024, NB = 4, SEQ = 4096, NTOK = NB * SEQ;
constexpr int NQKV = 3072, DIN = 3080, NEXP = 256, TOPK = 8, DEXP = 256;
constexpr float ALPHA = 1.189207115002721f;
constexpr float LN_EPS = 1e-5f, RMS_EPS = 1e-6f, ROUTED_SCALE = 2.5f;
constexpr float LOG2E = 1.4426950408889634f;
constexpr float QSCALE = 0.125f * LOG2E;
constexpr int LIST_CAP = NTOK;

constexpr size_t MiB = 1u << 20;
constexpr size_t WS_CTL = 0, CTL_ZERO_BYTES = 256 * 1024;
constexpr size_t WS_ADA = 1 * MiB;
constexpr size_t WS_WF = WS_ADA + 128 * 1024;
constexpr size_t WS_ADAP = 14 * MiB + 512 * 1024;
constexpr size_t WS_LOGF = 2 * MiB;
constexpr size_t WS_FCUM = WS_LOGF + 512 * 1024;
constexpr size_t WS_WIN = 3 * MiB;
constexpr size_t WS_WOUT = 9 * MiB;
constexpr size_t WS_WR = 11 * MiB;
constexpr size_t WS_WSGU = 12 * MiB;
constexpr size_t WS_WSD = 13 * MiB;
constexpr size_t WS_TOPW = 14 * MiB;
constexpr size_t WS_X1 = 16 * MiB;
constexpr size_t WS_U2 = 80 * MiB;
constexpr size_t WS_HS = 144 * MiB;
constexpr size_t WS_LIST = 152 * MiB;
constexpr size_t WS_H = 176 * MiB;
constexpr size_t WS_YS = 280 * MiB;
constexpr size_t WS_Y = 312 * MiB;
constexpr size_t WS_U1 = 312 * MiB;
constexpr size_t WS_QK = 344 * MiB;
constexpr size_t WS_VT = 440 * MiB;
constexpr size_t WS_O = 472 * MiB;
constexpr size_t WS_LOG = 504 * MiB;
constexpr size_t WS_WGU = 568 * MiB;
constexpr size_t WS_WD = 824 * MiB;
constexpr size_t WS_END = 952 * MiB;
constexpr int CW_CNT = 1024;
constexpr int CW_BAR = 4096;

constexpr int RING_BYTES = 131072;
constexpr int LDSCTL_OFF = RING_BYTES;
constexpr int TS_OFF = RING_BYTES + 256;
constexpr int LDS_BYTES = 147456;
constexpr int NWAVES = 8, NTHR = 512;

#define RLX_AGENT __ATOMIC_RELAXED, __HIP_MEMORY_SCOPE_AGENT
#define LDS_WAIT() asm volatile("s_waitcnt lgkmcnt(0)" ::: "memory")
#define VM_WAIT() asm volatile("s_waitcnt vmcnt(0)" ::: "memory")
__device__ __forceinline__ unsigned f2bf(float f) { unsigned u = __builtin_bit_cast(unsigned, f); return (u + 0x7fffu + ((u >> 16) & 1u)) >> 16; }
__device__ __forceinline__ unsigned pk2(float lo, float hi) { return f2bf(lo) | (f2bf(hi) << 16); }
__device__ __forceinline__ float bf2f(unsigned h) { return __builtin_bit_cast(float, h << 16); }
__device__ __forceinline__ unsigned cvt_pk_bf16(float lo, float hi) { unsigned r; asm volatile("v_cvt_pk_bf16_f32 %0, %1, %2" : "=v"(r) : "v"(lo), "v"(hi)); return r; }
__device__ __forceinline__ float wave_sum(float v) {
#pragma unroll
    for (int o = 1; o < 64; o <<= 1) v += __shfl_xor(v, o);
    return v;
}

#define XB_TMO      128
#define XB_XCNT(j)  (256  + 64 * (j))
#define XB_XSUB(j)  (1280 + 64 * (j))
#define XB_XGEN(j)  (2304 + 64 * (j))
#define XB_TOP      3328
#define XB_TOPGEN   3392
#define XCD_BAR_WORDS 3456
#define XB_SPIN_CAP (1u << 18)
__device__ __forceinline__ unsigned xb_ld(unsigned* p)              { return __hip_atomic_load(p, __ATOMIC_RELAXED, __HIP_MEMORY_SCOPE_AGENT); }
__device__ __forceinline__ unsigned xb_add(unsigned* p, unsigned v) { return __hip_atomic_fetch_add(p, v, __ATOMIC_RELAXED, __HIP_MEMORY_SCOPE_AGENT); }
__device__ __forceinline__ unsigned xb_xcc_id() { return (unsigned)__builtin_amdgcn_s_getreg((3 << 11) | 20) & 0xFu; }
#define XB_SPIN(cond, bar) do { unsigned _sp = 0; while (cond) { __builtin_amdgcn_s_sleep(1); \
    if ((++_sp & 255u) == 0u) { if (xb_ld(&(bar)[XB_TMO])) break; if (_sp > XB_SPIN_CAP) { atomicAdd(&(bar)[XB_TMO], 1u); break; } } } } while (0)
struct XcdBarrier { unsigned* bar; unsigned x; volatile LAS unsigned* st; };
__device__ __forceinline__ XcdBarrier xcd_barrier_post(unsigned* bar, volatile LAS unsigned* st) {
    XcdBarrier b; b.bar = bar; b.x = xb_xcc_id(); b.st = st;
    if (threadIdx.x == 0) (void)xb_add(&bar[XB_XCNT(b.x)], 1u);
    return b;
}
__device__ __forceinline__ void xcd_barrier_complete(unsigned* bar, unsigned x, unsigned& nloc, unsigned& nx) {
    const unsigned G = gridDim.x * gridDim.y * gridDim.z;
    unsigned sum, cnt, mine, sp = 0u;
    for (;;) {
        sum = 0u; cnt = 0u; mine = 0u;
#pragma unroll
        for (unsigned j = 0; j < 16; ++j) { const unsigned c = xb_ld(&bar[XB_XCNT(j)]); sum += c; cnt += (c > 0u) ? 1u : 0u; mine = (j == x) ? c : mine; }
        if (sum == G) break;
        __builtin_amdgcn_s_sleep(1);
        if ((++sp & 255u) == 0u) { if (xb_ld(&bar[XB_TMO])) break; if (sp > XB_SPIN_CAP) { atomicAdd(&bar[XB_TMO], 1u); break; } }
    }
    nloc = mine > 0u ? mine : 1u; nx = cnt > 0u ? cnt : 1u;
}
__device__ __forceinline__ void xcd_barrier(const XcdBarrier& b) {
    asm volatile("s_waitcnt vmcnt(0)" ::: "memory");
    __syncthreads();
    if (threadIdx.x == 0) {
        unsigned* bar = b.bar;
        __builtin_amdgcn_s_waitcnt(0);
        unsigned nloc = b.st[0], nx = b.st[1];
        if (nloc == 0u) { xcd_barrier_complete(bar, b.x, nloc, nx); b.st[0] = nloc; b.st[1] = nx; }
        const unsigned old = xb_add(&bar[XB_XSUB(b.x)], 1u);
        const unsigned gen = old / nloc;
        if (old + 1u == (gen + 1u) * nloc) {
            __builtin_amdgcn_fence(__ATOMIC_RELEASE, "agent");
            asm volatile("s_waitcnt vmcnt(0)" ::: "memory");
            const unsigned og = xb_add(&bar[XB_TOP], 1u);
            const unsigned tg = og / nx;
            if (og + 1u == (tg + 1u) * nx) xb_add(&bar[XB_TOPGEN], 1u);
            else XB_SPIN(xb_ld(&bar[XB_TOPGEN]) == tg, bar);
            __builtin_amdgcn_fence(__ATOMIC_ACQUIRE, "agent");
            xb_add(&bar[XB_XGEN(b.x)], 1u);
            asm volatile("s_waitcnt vmcnt(0)" ::: "memory");
        } else {
            XB_SPIN(xb_ld(&bar[XB_XGEN(b.x)]) == gen, bar);
            __builtin_amdgcn_fence(__ATOMIC_ACQUIRE, "agent");
            asm volatile("s_waitcnt vmcnt(0)" ::: "memory");
        }
    }
    __syncthreads();
}

namespace pg8 {
constexpr int BM = 256, BK = 64, HALF = 128, HTB = HALF * BK * 2, STAGE_BYTES = 8 * HTB;
__device__ __forceinline__ int lds_byte(int r, int c) { const int st = (r >> 4) * 2 + (c >> 5), rr = r & 15, cc = c & 31, ob = rr * 64 + cc * 2; return st * 1024 + (ob ^ (((ob >> 9) & 1) << 5)); }
__device__ __forceinline__ void stage_rc(int b, int& R, int& C) { const int st = b / 1024, sb = b % 1024, swz = sb ^ (((sb >> 9) & 1) << 5); R = (st >> 1) * 16 + swz / 64; C = (st & 1) * 32 + (swz % 64) / 2; }
__device__ __forceinline__ int perm32(int rho) { const int n = rho >> 4, i = rho & 15; return 8 * (i >> 2) + 4 * n + (i & 3); }

struct Unit { int pm, pn, e, cnt; };

template <class P>
__device__ __forceinline__ void gemm_phase(LAS unsigned char* lds, const P& prob) {
    const int tid = threadIdx.x, wid = __builtin_amdgcn_readfirstlane(tid >> 6), lane = tid & 63, wr = wid >> 2, wc = wid & 3, fr = lane & 15, fq = lane >> 4;
    const int nt = prob.K / BK;
    int Rr[2]; unsigned voffA[2], voffB[2];
#pragma unroll
    for (int i = 0; i < 2; ++i) { int R, C; stage_rc(tid * 16 + i * 8192, R, C); Rr[i] = R; const int Rb = P::PERM ? ((R & ~31) + perm32(R & 31)) : R;
        voffA[i] = P::GATHER ? (unsigned)(C * 2) : (unsigned)(R * prob.lda + C * 2); voffB[i] = (unsigned)(Rb * prob.ldb + C * 2); }
    const size_t kstep = (size_t)(BK * 2);
    const size_t hA = P::GATHER ? 0 : (size_t)HALF * prob.lda, hB = (size_t)HALF * prob.ldb;
    const unsigned ldsw = (unsigned)wid * 1024u;
    const int aoff = lds_byte(wr * 64 + fr, fq * 8), boff = lds_byte(wc * 32 + fr, fq * 8);
#define PG8_SA(b, h) (((b) * 2 + (h)) * HTB)
#define PG8_SB(b, h) ((4 + (b) * 2 + (h)) * HTB)
#define PG8_STAGE(bufoff, gbase, voff) do { _Pragma("unroll") for (int _i = 0; _i < 2; ++_i) \
        __builtin_amdgcn_global_load_lds((const unsigned*)((const char*)(gbase) + (voff)[_i]), (LAS unsigned*)(lds + (bufoff) + ldsw + _i * 8192), 16, 0, 0); } while (0)
#define PG8_LDA(dst, b, h) do { _Pragma("unroll") for (int m = 0; m < 4; ++m) _Pragma("unroll") for (int k = 0; k < 2; ++k) dst[m][k] = *(const LAS bf16x8*)(lds + PG8_SA(b, h) + aoff + m * 2048 + k * 1024); } while (0)
#define PG8_LDB(dst, b, h) do { _Pragma("unroll") for (int n = 0; n < 2; ++n) _Pragma("unroll") for (int k = 0; k < 2; ++k) dst[n][k] = *(const LAS bf16x8*)(lds + PG8_SB(b, h) + boff + n * 2048 + k * 1024); } while (0)
#define PG8_MMA(ai, bj, At, Bt) do { __builtin_amdgcn_s_setprio(1); _Pragma("unroll") for (int m = 0; m < 4; ++m) _Pragma("unroll") for (int n = 0; n < 2; ++n) _Pragma("unroll") for (int k = 0; k < 2; ++k) \
        acc[ai][bj][m][n] = P::SWAP ? __builtin_amdgcn_mfma_f32_16x16x32_bf16(At[m][k], Bt[n][k], acc[ai][bj][m][n], 0, 0, 0) \
                                    : __builtin_amdgcn_mfma_f32_16x16x32_bf16(Bt[n][k], At[m][k], acc[ai][bj][m][n], 0, 0, 0); __builtin_amdgcn_s_setprio(0); } while (0)
#define PG8_WAIT_V(n) asm volatile("s_waitcnt vmcnt(" #n ")" ::: "memory")
#define PG8_WAIT_L(n) asm volatile("s_waitcnt lgkmcnt(" #n ")" ::: "memory")
#define PG8_BAR __builtin_amdgcn_s_barrier()
#define PG8_SCHED __builtin_amdgcn_sched_barrier(0)
#define PG8_STAGE_A(bufoff, base, kb, h, og) do { if constexpr (P::GATHER) { unsigned _v[2] = {og[h][0] + voffA[0], og[h][1] + voffA[1]}; PG8_STAGE(bufoff, gA + (kb), _v); } \
        else { PG8_STAGE(bufoff, gA + (base) + (kb) + (h) * hA, voffA); } } while (0)
#define PG8_STAGE_B(bufoff, base, kb, h) PG8_STAGE(bufoff, gB + (base) + (kb) + (h) * hB, voffB)
#define PG8_GOFFS(u, og) do { if constexpr (P::GATHER) { _Pragma("unroll") for (int _h = 0; _h < 2; ++_h) _Pragma("unroll") for (int _i = 0; _i < 2; ++_i) og[_h][_i] = prob.a_row(u, _h * HALF + Rr[_i]); } } while (0)
    Unit cur, nxt; int ui = 0;
    if (!prob.next(0, cur)) return;
    f32x4 acc[2][2][4][2];
#pragma unroll
    for (int a = 0; a < 2; ++a)
#pragma unroll
        for (int b = 0; b < 2; ++b)
#pragma unroll
            for (int m = 0; m < 4; ++m)
#pragma unroll
                for (int n = 0; n < 2; ++n) acc[a][b][m][n] = (f32x4){0.f, 0.f, 0.f, 0.f};
    bf16x8 At[4][2], B0[2][2], B1[2][2];
    unsigned ogc[2][2] = {{0u, 0u}, {0u, 0u}}, ogn[2][2] = {{0u, 0u}, {0u, 0u}};
    PG8_GOFFS(cur, ogc);
    const char* const gA = prob.A; const char* const gB = prob.B;
    size_t cAb = P::GATHER ? 0 : prob.a_base(cur), cBb = prob.b_base(cur);
    PG8_STAGE_B(PG8_SB(0, 0), cBb, 0, 0); PG8_STAGE_B(PG8_SB(0, 1), cBb, 0, 1); PG8_STAGE_A(PG8_SA(0, 0), cAb, 0, 0, ogc); PG8_STAGE_A(PG8_SA(0, 1), cAb, 0, 1, ogc);
    if (wr == 1) PG8_BAR;
    PG8_WAIT_V(2); PG8_BAR;
    PG8_STAGE_B(PG8_SB(1, 0), cBb, kstep, 0); PG8_STAGE_A(PG8_SA(1, 0), cAb, kstep, 0, ogc); PG8_STAGE_B(PG8_SB(1, 1), cBb, kstep, 1);
    PG8_WAIT_V(6); PG8_BAR;
    for (;;) {
        const bool has_next = prob.next(ui + 1, nxt);
        size_t nAb = cAb, nBb = cBb;
        if (has_next) { nAb = P::GATHER ? 0 : prob.a_base(nxt); nBb = prob.b_base(nxt); }
        for (int t = 0; t < nt; t += 2) {
            const bool last = (t == nt - 2);
            const size_t k1 = (size_t)(t + 1) * kstep;
            const size_t k2 = last ? 0 : (size_t)(t + 2) * kstep, k3 = k2 + kstep;
            const size_t a2 = last ? nAb : cAb, b2 = last ? nBb : cBb;
            if constexpr (P::GATHER) if (last) { if (has_next) { PG8_GOFFS(nxt, ogn); } else {
#pragma unroll
                for (int h = 0; h < 2; ++h)
#pragma unroll
                    for (int i = 0; i < 2; ++i) ogn[h][i] = ogc[h][i]; } }
            unsigned og2[2][2];
#pragma unroll
            for (int h = 0; h < 2; ++h)
#pragma unroll
                for (int i = 0; i < 2; ++i) og2[h][i] = (P::GATHER && last) ? ogn[h][i] : ogc[h][i];
            PG8_LDB(B0, 0, 0); PG8_LDB(B1, 0, 1); PG8_SCHED; PG8_LDA(At, 0, 0); PG8_STAGE_A(PG8_SA(1, 1), cAb, k1, 1, ogc);
            PG8_WAIT_V(8); PG8_WAIT_L(0); PG8_BAR; PG8_MMA(0, 0, At, B0); PG8_MMA(0, 1, At, B1); PG8_BAR; PG8_SCHED;
            PG8_LDA(At, 0, 1); PG8_STAGE_B(PG8_SB(0, 0), b2, k2, 0); PG8_STAGE_B(PG8_SB(0, 1), b2, k2, 1); PG8_STAGE_A(PG8_SA(0, 0), a2, k2, 0, og2);
            PG8_WAIT_V(8); PG8_WAIT_L(0); PG8_BAR; PG8_MMA(1, 0, At, B0); PG8_MMA(1, 1, At, B1); PG8_BAR; PG8_SCHED;
            PG8_LDB(B0, 1, 0); PG8_LDB(B1, 1, 1); PG8_SCHED; PG8_LDA(At, 1, 0); PG8_STAGE_A(PG8_SA(0, 1), a2, k2, 1, og2);
            PG8_WAIT_V(8); PG8_WAIT_L(0); PG8_BAR; PG8_MMA(0, 0, At, B0); PG8_MMA(0, 1, At, B1); PG8_BAR; PG8_SCHED;
            PG8_LDA(At, 1, 1); PG8_STAGE_B(PG8_SB(1, 0), b2, k3, 0); PG8_STAGE_B(PG8_SB(1, 1), b2, k3, 1); PG8_STAGE_A(PG8_SA(1, 0), a2, k3, 0, og2);
            PG8_WAIT_V(8); PG8_WAIT_L(0); PG8_BAR; PG8_MMA(1, 0, At, B0); PG8_MMA(1, 1, At, B1); PG8_BAR; PG8_SCHED;
        }
        if (wr == 0) PG8_BAR;
        prob.epi(acc, cur, wr, wc, fr, fq);
        if (!has_next) break;
#pragma unroll
        for (int a = 0; a < 2; ++a)
#pragma unroll
            for (int b = 0; b < 2; ++b)
#pragma unroll
                for (int m = 0; m < 4; ++m)
#pragma unroll
                    for (int n = 0; n < 2; ++n) acc[a][b][m][n] = (f32x4){0.f, 0.f, 0.f, 0.f};
        cur = nxt; ++ui; cAb = nAb; cBb = nBb;
#pragma unroll
        for (int h = 0; h < 2; ++h)
#pragma unroll
            for (int i = 0; i < 2; ++i) ogc[h][i] = ogn[h][i];
        if (wr == 1) PG8_BAR;
    }
    PG8_WAIT_V(0);
    PG8_BAR;
#undef PG8_SA
#undef PG8_SB
#undef PG8_STAGE
#undef PG8_STAGE_A
#undef PG8_STAGE_B
#undef PG8_GOFFS
#undef PG8_LDA
#undef PG8_LDB
#undef PG8_MMA
#undef PG8_WAIT_V
#undef PG8_WAIT_L
#undef PG8_BAR
#undef PG8_SCHED
}
}
using pg8::Unit;

__device__ __forceinline__ bool static_tile(int i, int G, int c, int nM, int nN, int& pm, int& pn) {
    const int nwg = nM * nN; const long L = (long)i * G + c; if (L >= nwg) return false;
    int wgid = (int)L; { const int q = nwg / 8, r = nwg % 8, xcd = wgid % 8, off = wgid / 8; wgid = (xcd < r ? xcd * (q + 1) : r * (q + 1) + (xcd - r) * q) + off; }
    const int WGM = 8, nig = WGM * nN, gid = wgid / nig, fm = gid * WGM, gsz = (nM - fm) < WGM ? (nM - fm) : WGM;
    pm = fm + ((wgid % nig) % gsz); pn = (wgid % nig) / gsz; return true;
}

struct Args { const float* in[21]; float* out; unsigned char* ws; };
struct Frame {
    LAS unsigned char* lds; unsigned char* ws; const float* const* in; float* out;
    int tid, lane, wave, G, vcu, bx;
};
enum { I_X = 0, I_C, I_WADA, I_BADA, I_WIN, I_BF, I_FOXG, I_SBG, I_WOUT, I_LN1G, I_LN1B, I_WR, I_RB, I_WGE, I_WUE, I_WDE, I_WGS, I_WUS, I_WDS, I_LN2G, I_LN2B };

__device__ __forceinline__ void transpose_item(const float* W, int ldw, int k0, int nsrc0, bf16_t* WT, bf16_t* WT_lo, int Kd, int drow0, LAS float* scr, int lane) {
#pragma unroll 8
    for (int i = 0; i < 32; ++i) { const int kk = 2 * i + (lane >> 5); scr[kk * 33 + (lane & 31)] = W[(size_t)(k0 + kk) * ldw + nsrc0 + (lane & 31)]; }
    LDS_WAIT(); asm volatile("" ::: "memory");
    const int c = lane & 7;
#pragma unroll
    for (int j = 0; j < 4; ++j) { const int n = (lane >> 3) + 8 * j; const LAS float* s = scr + (8 * c) * 33 + n;
        float v[8];
#pragma unroll
        for (int q = 0; q < 8; ++q) v[q] = s[q * 33];
        u32x4 o; o.x = pk2(v[0], v[1]); o.y = pk2(v[2], v[3]); o.z = pk2(v[4], v[5]); o.w = pk2(v[6], v[7]);
        *(GAS u32x4*)(WT + (size_t)(drow0 + n) * Kd + k0 + 8 * c) = o;
        if (WT_lo) {
            float r[8];
#pragma unroll
            for (int q = 0; q < 8; ++q) r[q] = v[q] - bf2f(f2bf(v[q]));
            u32x4 p; p.x = pk2(r[0], r[1]); p.y = pk2(r[2], r[3]); p.z = pk2(r[4], r[5]); p.w = pk2(r[6], r[7]);
            *(GAS u32x4*)(WT_lo + (size_t)(drow0 + n) * Kd + k0 + 8 * c) = p;
        } }
    LDS_WAIT(); asm volatile("" ::: "memory");
}

__device__ __forceinline__ void phase0(Frame& F) {
    const int gw = F.vcu * NWAVES + F.wave, NGW = F.G * NWAVES;
    unsigned char* ws = F.ws;
    LAS float* sc = (LAS float*)(F.lds);
    for (int i = F.tid; i < NB * DM; i += NTHR) { const float v = F.in[I_C][i]; sc[i] = v / (1.f + __expf(-v)); }
    __syncthreads();
    if (gw < 192) {
        const int nc = gw % 24, kq = gw / 24; const float* W = F.in[I_WADA];
        f32x4 a[4];
#pragma unroll
        for (int b = 0; b < 4; ++b) a[b] = (f32x4){0.f, 0.f, 0.f, 0.f};
        const int col = nc * 256 + F.lane * 4;
#pragma unroll 16
        for (int k = kq * 128; k < kq * 128 + 128; ++k) {
            const f32x4 w = *(const GAS f32x4*)(W + (size_t)k * 6144 + col);
#pragma unroll
            for (int b = 0; b < 4; ++b) a[b] += w * sc[b * DM + k];
        }
        float* part = (float*)(ws + WS_ADAP);
#pragma unroll
        for (int b = 0; b < 4; ++b) *(GAS f32x4*)(part + ((size_t)kq * 4 + b) * 6144 + col) = a[b];
    }
    { float* wf = (float*)(ws + WS_WF); const float* W = F.in[I_WIN];
      for (int i = F.bx * NTHR + F.tid; i < 8 * DM; i += F.G * NTHR) { const int hh = i >> 10, k = i & 1023; wf[i] = W[(size_t)k * DIN + NQKV + hh]; } }
    LAS float* scr = (LAS float*)(F.lds + 16384 + F.wave * 12288);
    bf16_t* win = (bf16_t*)(ws + WS_WIN); bf16_t* wout = (bf16_t*)(ws + WS_WOUT); bf16_t* wr = (bf16_t*)(ws + WS_WR);
    bf16_t* wsgu = (bf16_t*)(ws + WS_WSGU); bf16_t* wsd = (bf16_t*)(ws + WS_WSD); bf16_t* wgu = (bf16_t*)(ws + WS_WGU); bf16_t* wd = (bf16_t*)(ws + WS_WD);
    constexpr int I_IN = 16 * 96, I_OUT = 16 * 32, I_R = 16 * 8, I_SGU = 16 * 16, I_SD = 4 * 32, I_SMALL = I_IN + I_OUT + I_R + I_SGU + I_SD;
    constexpr int I_EGU = 16 * 16, I_ED = 4 * 32, I_E = I_EGU + I_ED;
    const int NITEMS = I_SMALL + NEXP * I_E;
    for (int it = gw; it < NITEMS; it += NGW) {
        int r = it;
        if (r < I_IN) { const int kb = r / 96, nb = r % 96; transpose_item(F.in[I_WIN], DIN, 64 * kb, 32 * nb, win, nullptr, DM, 32 * nb, scr, F.lane); continue; } r -= I_IN;
        if (r < I_OUT) { const int kb = r / 32, nb = r % 32; transpose_item(F.in[I_WOUT], DM, 64 * kb, 32 * nb, wout, nullptr, DM, 32 * nb, scr, F.lane); continue; } r -= I_OUT;
        if (r < I_R) { const int kb = r / 8, nb = r % 8; transpose_item(F.in[I_WR], NEXP, 64 * kb, 32 * nb, wr, wr + NEXP * DM, DM, 32 * nb, scr, F.lane); continue; } r -= I_R;
        if (r < I_SGU) { const int kb = r / 16, nb = r % 16, ct = nb >> 3, half = (nb >> 2) & 1, jb = nb & 3;
            transpose_item(half ? F.in[I_WUS] : F.in[I_WGS], DEXP, 64 * kb, 128 * ct + 32 * jb, wsgu, nullptr, DM, 32 * nb, scr, F.lane); continue; } r -= I_SGU;
        if (r < I_SD) { const int kb = r / 32, nb = r % 32; transpose_item(F.in[I_WDS], DM, 64 * kb, 32 * nb, wsd, nullptr, DEXP, 32 * nb, scr, F.lane); continue; } r -= I_SD;
        const int e = r / I_E; r -= e * I_E;
        if (r < I_EGU) { const int kb = r / 16, nb = r % 16, ct = nb >> 3, half = (nb >> 2) & 1, jb = nb & 3;
            const float* src = (half ? F.in[I_WUE] : F.in[I_WGE]) + (size_t)e * DM * DEXP;
            transpose_item(src, DEXP, 64 * kb, 128 * ct + 32 * jb, wgu + (size_t)e * 512 * DM, nullptr, DM, 32 * nb, scr, F.lane); continue; } r -= I_EGU;
        { const int kb = r / 32, nb = r % 32; transpose_item(F.in[I_WDE] + (size_t)e * DEXP * DM, DM, 64 * kb, 32 * nb, wd + (size_t)e * DM * DEXP, nullptr, DEXP, 32 * nb, scr, F.lane); }
    }
}

__device__ __forceinline__ float ada_from_partials(const float* part, const float* bada, int b, int j) {
    float a = 0.f;
#pragma unroll
    for (int q = 0; q < 8; ++q) a += part[(q * 4 + b) * 6144 + j];
    return bada[j] + a;
}
__device__ __forceinline__ void phase1(Frame& F) {
    unsigned char* ws = F.ws; const float* part = (const float*)(ws + WS_ADAP); const float* bada = F.in[I_BADA];
    LAS float* tab = (LAS float*)F.lds;
    for (int i = F.tid; i < NB * 2 * DM; i += NTHR) { const int b = i >> 11, which = (i >> 10) & 1, d = i & 1023;
        const float v = ada_from_partials(part, bada, b, (which == 0 ? 1024 : 0) + d); tab[i] = which == 0 ? 1.f + v : v; }
    { float* ada = (float*)(ws + WS_ADA);
      for (int j = F.bx * NTHR + F.tid; j < NB * 6144; j += F.G * NTHR) ada[j] = ada_from_partials(part, bada, j / 6144, j % 6144); }
    __syncthreads();
    const int gw = F.vcu * NWAVES + F.wave, NGW = F.G * NWAVES;
    const float* x = F.in[I_X]; bf16_t* u1 = (bf16_t*)(ws + WS_U1); const float* wf = (const float*)(ws + WS_WF); float* logf = (float*)(ws + WS_LOGF);
    for (int m = gw; m < NTOK; m += NGW) {
        const int b = m >> 12, s = m & 4095;
        f32x4 u[4];
#pragma unroll
        for (int j = 0; j < 4; ++j) { const int d = 4 * F.lane + 256 * j; const f32x4 xv = *(const GAS f32x4*)(x + (size_t)m * DM + d);
            const f32x4 sc = *(const LAS f32x4*)(tab + (b * 2 + 0) * DM + d), sh = *(const LAS f32x4*)(tab + (b * 2 + 1) * DM + d);
            u[j] = xv * sc + sh;
            u32x2 w; w.x = pk2(u[j][0], u[j][1]); w.y = pk2(u[j][2], u[j][3]); *(GAS u32x2*)(u1 + (size_t)m * DM + d) = w; }
        float fl[8];
#pragma unroll
        for (int hh = 0; hh < 8; ++hh) { float a = 0.f;
#pragma unroll
            for (int j = 0; j < 4; ++j) { const f32x4 w = *(const GAS f32x4*)(wf + hh * DM + 4 * F.lane + 256 * j); a += (u[j][0] * w[0] + u[j][1] * w[1]) + (u[j][2] * w[2] + u[j][3] * w[3]); }
            fl[hh] = wave_sum(a); }
        if (F.lane < 8) { float v = 0.f;
#pragma unroll
            for (int hh = 0; hh < 8; ++hh) v = (F.lane == hh) ? fl[hh] : v;
            v += F.in[I_BF][F.lane];
            const float ls = fminf(v, 0.f) - log1pf(expf(-fabsf(v)));
            logf[((size_t)(b * 8 + F.lane)) * SEQ + s] = ls * LOG2E; }
    }
}

__device__ __forceinline__ void fcum_block(Frame& F, int seq) {
    const float* logf = (const float*)(F.ws + WS_LOGF) + (size_t)seq * SEQ; float* fc = (float*)(F.ws + WS_FCUM) + (size_t)seq * SEQ;
    LAS float* part = (LAS float*)F.lds;
    float v[8]; float run = 0.f;
#pragma unroll
    for (int i = 0; i < 8; ++i) { run += logf[F.tid * 8 + i]; v[i] = run; }
    part[F.tid] = run; __syncthreads();
    if (F.tid == 0) { float a = 0.f; for (int i = 0; i < NTHR; ++i) { const float t = part[i]; part[i] = a; a += t; } }
    __syncthreads();
    const float base = part[F.tid];
#pragma unroll
    for (int i = 0; i < 8; ++i) fc[F.tid * 8 + i] = base + v[i];
    __syncthreads();
}

struct ProbQK {
    static constexpr bool PERM = true, SWAP = false, GATHER = false;
    const char* A; const char* B; int K, lda, ldb; int G, c; bf16_t* qk;
    __device__ __forceinline__ bool next(int i, Unit& u) const { int pm, pn; if (!static_tile(i, G, c, 64, 8, pm, pn)) return false; u.pm = pm; u.pn = pn < 4 ? pn : pn + 2; u.e = -1; u.cnt = 0; return true; }
    __device__ __forceinline__ size_t a_base(const Unit& u) const { return (size_t)(u.pm * 256) * 2048u; }
    __device__ __forceinline__ size_t b_base(const Unit& u) const { return (size_t)(u.pn * 256) * 2048u; }
    __device__ __forceinline__ void epi(const f32x4 (&acc)[2][2][4][2], const Unit& u, int wr, int wc, int fr, int fq) const {
        const float sc = (u.pn == 0 || u.pn == 1 || u.pn == 6 || u.pn == 7) ? QSCALE : 1.f;
#pragma unroll
        for (int ai = 0; ai < 2; ++ai)
#pragma unroll
            for (int m = 0; m < 4; ++m) { bf16_t* rowp = qk + (size_t)(u.pm * 256 + ai * 128 + wr * 64 + m * 16 + fr) * NQKV + u.pn * 256 + wc * 32 + 8 * fq;
#pragma unroll
                for (int bj = 0; bj < 2; ++bj) { const f32x4 v0 = acc[ai][bj][m][0] * sc, v1 = acc[ai][bj][m][1] * sc; u32x4 w;
                    w.x = cvt_pk_bf16(v0[0], v0[1]); w.y = cvt_pk_bf16(v0[2], v0[3]); w.z = cvt_pk_bf16(v1[0], v1[1]); w.w = cvt_pk_bf16(v1[2], v1[3]);
                    *(GAS u32x4*)(rowp + bj * 128) = w; } }
    }
};
struct ProbVT {
    static constexpr bool PERM = false, SWAP = true, GATHER = false;
    const char* A; const char* B; int K, lda, ldb; int G, c; bf16_t* vt;
    __device__ __forceinline__ bool next(int i, Unit& u) const { int pm, pn; if (!static_tile(i, G, c, 64, 4, pm, pn)) return false; u.pm = pm; u.pn = pn < 2 ? 4 + pn : 8 + pn; u.e = -1; u.cnt = 0; return true; }
    __device__ __forceinline__ size_t a_base(const Unit& u) const { return (size_t)(u.pm * 256) * 2048u; }
    __device__ __forceinline__ size_t b_base(const Unit& u) const { return (size_t)(u.pn * 256) * 2048u; }
    __device__ __forceinline__ void epi(const f32x4 (&acc)[2][2][4][2], const Unit& u, int wr, int wc, int fr, int fq) const {
        const int hg0 = (u.pn < 6) ? (u.pn - 4) * 4 : 8 + (u.pn - 10) * 4;
#pragma unroll
        for (int bj = 0; bj < 2; ++bj)
#pragma unroll
            for (int n = 0; n < 2; ++n) { const int cl = bj * 128 + wc * 32 + n * 16 + fr, hg = hg0 + (cl >> 6), d = cl & 63;
#pragma unroll
                for (int ai = 0; ai < 2; ++ai)
#pragma unroll
                    for (int m = 0; m < 4; ++m) { const int row = u.pm * 256 + ai * 128 + wr * 64 + m * 16 + 4 * fq, b = row >> 12, s = row & 4095;
                        const f32x4 v = acc[ai][bj][m][n]; u32x2 w; w.x = cvt_pk_bf16(v[0], v[1]); w.y = cvt_pk_bf16(v[2], v[3]);
                        *(GAS u32x2*)(vt + ((size_t)((b * 16 + hg) * 64 + d)) * SEQ + s) = w; } }
    }
};
struct ProbZ {
    static constexpr bool PERM = false, SWAP = false, GATHER = false;
    const char* A; const char* B; int K, lda, ldb; int G, c; const float* x; const float* ada; float* z;
    __device__ __forceinline__ bool next(int i, Unit& u) const { int pm, pn; if (!static_tile(i, G, c, 64, 4, pm, pn)) return false; u.pm = pm; u.pn = pn; u.e = -1; u.cnt = 0; return true; }
    __device__ __forceinline__ size_t a_base(const Unit& u) const { return (size_t)(u.pm * 256) * 2048u; }
    __device__ __forceinline__ size_t b_base(const Unit& u) const { return (size_t)(u.pn * 256) * 2048u; }
    __device__ __forceinline__ void epi(const f32x4 (&acc)[2][2][4][2], const Unit& u, int wr, int wc, int fr, int fq) const {
        const int b = (u.pm * 256) >> 12; const int col0 = u.pn * 256 + wc * 32 + 4 * fq;
#pragma unroll
        for (int bj = 0; bj < 2; ++bj)
#pragma unroll
            for (int n = 0; n < 2; ++n) { const int col = col0 + bj * 128 + n * 16; const f32x4 gv = *(const GAS f32x4*)(ada + b * 6144 + 2048 + col) + 1.0f;
#pragma unroll
                for (int ai = 0; ai < 2; ++ai)
#pragma unroll
                    for (int m = 0; m < 4; ++m) { const size_t off = (size_t)(u.pm * 256 + ai * 128 + wr * 64 + m * 16 + fr) * DM + col;
                        const f32x4 xv = *(const GAS f32x4*)(x + off); *(GAS f32x4*)(z + off) = xv * ALPHA + gv * acc[ai][bj][m][n]; } }
    }
};
struct ProbP6 {
    static constexpr bool PERM = true, SWAP = false, GATHER = false;
    const char* A; const char* B; int K, lda, ldb; int G, c; float* logits; bf16_t* hs;
    __device__ __forceinline__ bool next(int i, Unit& u) const { const int L = i * G + c; if (L >= 192 + 128) return false;
        if (L < 192) { u.pm = L / 3; u.e = L % 3; u.pn = 0; } else { u.pm = (L - 192) >> 1; u.pn = (L - 192) & 1; u.e = -1; } u.cnt = 0; return true; }
    __device__ __forceinline__ size_t a_base(const Unit& u) const { return (size_t)(u.pm * 256) * 4096u + (u.e == 1 ? 2048u : 0u); }
    __device__ __forceinline__ size_t b_base(const Unit& u) const {
        if (u.e >= 0) return (size_t)(u.e == 2 ? 256 : 0) * 2048u;
        return (size_t)(WS_WSGU - WS_WR) + (size_t)(u.pn * 256) * 2048u; }
    __device__ __forceinline__ void epi(const f32x4 (&acc)[2][2][4][2], const Unit& u, int wr, int wc, int fr, int fq) const {
        if (u.e >= 0) {
            float* out = logits + (size_t)u.e * NTOK * NEXP;
#pragma unroll
            for (int ai = 0; ai < 2; ++ai)
#pragma unroll
                for (int m = 0; m < 4; ++m) { float* rowp = out + (size_t)(u.pm * 256 + ai * 128 + wr * 64 + m * 16 + fr) * NEXP + wc * 32 + 8 * fq;
#pragma unroll
                    for (int bj = 0; bj < 2; ++bj) { *(GAS f32x4*)(rowp + bj * 128) = acc[ai][bj][m][0]; *(GAS f32x4*)(rowp + bj * 128 + 4) = acc[ai][bj][m][1]; } }
        } else {
#pragma unroll
            for (int ai = 0; ai < 2; ++ai)
#pragma unroll
                for (int m = 0; m < 4; ++m) { bf16_t* rowp = hs + (size_t)(u.pm * 256 + ai * 128 + wr * 64 + m * 16 + fr) * DEXP + u.pn * 128 + wc * 32 + 8 * fq;
                    float h[8];
#pragma unroll
                    for (int n = 0; n < 2; ++n)
#pragma unroll
                        for (int q = 0; q < 4; ++q) { const float g = acc[ai][0][m][n][q], up = acc[ai][1][m][n][q]; h[n * 4 + q] = g / (1.f + __expf(-g)) * up; }
                    u32x4 w; w.x = cvt_pk_bf16(h[0], h[1]); w.y = cvt_pk_bf16(h[2], h[3]); w.z = cvt_pk_bf16(h[4], h[5]); w.w = cvt_pk_bf16(h[6], h[7]);
                    *(GAS u32x4*)rowp = w; }
        }
    }
};
struct ExpTab { const LAS int* ts; int NT; const unsigned* cnt; const int* list; };
__device__ __forceinline__ int exp_of_tile(const ExpTab& T, int tile) { int lo = 0, hi = NEXP;
    while (hi - lo > 1) { const int mid = (lo + hi) >> 1; if (T.ts[mid] <= tile) lo = mid; else hi = mid; } return lo; }
struct ProbP8 {
    static constexpr bool PERM = true, SWAP = false, GATHER = true;
    const char* A; const char* B; int K, lda, ldb; int G, c; ExpTab T; bf16_t* h;
    __device__ __forceinline__ bool next(int i, Unit& u) const { const int L = i * G + c; if (L >= T.NT * 2) return false; const int tile = L >> 1; u.pn = L & 1;
        const int e = exp_of_tile(T, tile); u.e = e; u.pm = tile; u.cnt = (int)T.cnt[e] - 256 * (tile - T.ts[e]); return true; }
    __device__ __forceinline__ size_t a_base(const Unit&) const { return 0; }
    __device__ __forceinline__ unsigned a_row(const Unit& u, int r) const { const int pos = r < u.cnt ? 256 * (u.pm - T.ts[u.e]) + r : 0; const int a = T.list[(size_t)u.e * LIST_CAP + pos]; return (unsigned)(a >> 3) * 4096u; }
    __device__ __forceinline__ size_t b_base(const Unit& u) const { return (size_t)(u.e * 512 + u.pn * 256) * 2048u; }
    __device__ __forceinline__ void epi(const f32x4 (&acc)[2][2][4][2], const Unit& u, int wr, int wc, int fr, int fq) const {
#pragma unroll
        for (int ai = 0; ai < 2; ++ai)
#pragma unroll
            for (int m = 0; m < 4; ++m) { bf16_t* rowp = h + (size_t)(u.pm * 256 + ai * 128 + wr * 64 + m * 16 + fr) * DEXP + u.pn * 128 + wc * 32 + 8 * fq;
                float hv[8];
#pragma unroll
                for (int n = 0; n < 2; ++n)
#pragma unroll
                    for (int q = 0; q < 4; ++q) { const float g = acc[ai][0][m][n][q], up = acc[ai][1][m][n][q]; hv[n * 4 + q] = g / (1.f + __expf(-g)) * up; }
                u32x4 w; w.x = cvt_pk_bf16(hv[0], hv[1]); w.y = cvt_pk_bf16(hv[2], hv[3]); w.z = cvt_pk_bf16(hv[4], hv[5]); w.w = cvt_pk_bf16(hv[6], hv[7]);
                *(GAS u32x4*)rowp = w; }
    }
};
struct ProbP9 {
    static constexpr bool PERM = true, SWAP = false, GATHER = false;
    const char* A; const char* B; int K, lda, ldb; int G, c; ExpTab T; const float* topw; bf16_t* y; bf16_t* ys;
    __device__ __forceinline__ bool next(int i, Unit& u) const { const int L = i * G + c; const int NR = T.NT * 4; if (L >= NR + 256) return false;
        if (L < NR) { const int tile = L >> 2; u.pn = L & 3; const int e = exp_of_tile(T, tile); u.e = e; u.pm = tile; u.cnt = (int)T.cnt[e] - 256 * (tile - T.ts[e]); }
        else { const int q = L - NR; u.pm = q >> 2; u.pn = q & 3; u.e = -1; u.cnt = 256; } return true; }
    __device__ __forceinline__ size_t a_base(const Unit& u) const { return (u.e >= 0 ? (size_t)(WS_H - WS_HS) : (size_t)0) + (size_t)(u.pm * 256) * 512u; }
    __device__ __forceinline__ size_t b_base(const Unit& u) const { return u.e >= 0 ? (size_t)(WS_WD - WS_WSD) + (size_t)(u.e * 1024 + u.pn * 256) * 512u : (size_t)(u.pn * 256) * 512u; }
    __device__ __forceinline__ void epi(const f32x4 (&acc)[2][2][4][2], const Unit& u, int wr, int wc, int fr, int fq) const {
#pragma unroll
        for (int ai = 0; ai < 2; ++ai)
#pragma unroll
            for (int m = 0; m < 4; ++m) { const int r = ai * 128 + wr * 64 + m * 16 + fr;
                float w = 1.f; bool ok = true; size_t roff;
                if (u.e >= 0) { ok = r < u.cnt; const int pos = ok ? 256 * (u.pm - T.ts[u.e]) + r : 0; const int a = T.list[(size_t)u.e * LIST_CAP + pos]; w = topw[a]; roff = (size_t)(WS_Y - WS_YS) + (size_t)a * (DM * 2); }
                else roff = (size_t)(u.pm * 256 + r) * (DM * 2);
                bf16_t* rowp = (bf16_t*)((unsigned char*)ys + roff) + u.pn * 256 + wc * 32 + 8 * fq;
                if (ok) {
#pragma unroll
                    for (int bj = 0; bj < 2; ++bj) { const f32x4 v0 = acc[ai][bj][m][0] * w, v1 = acc[ai][bj][m][1] * w; u32x4 o;
                        o.x = cvt_pk_bf16(v0[0], v0[1]); o.y = cvt_pk_bf16(v0[2], v0[3]); o.z = cvt_pk_bf16(v1[0], v1[1]); o.w = cvt_pk_bf16(v1[2], v1[3]);
                        *(GAS u32x4*)(rowp + bj * 128) = o; } } }
    }
};

constexpr int AT_TILE = 8192;
constexpr int AT_K = 0, AT_V = 2 * AT_TILE, AT_F = 4 * AT_TILE, AT_BUF = 4 * AT_TILE + 512;
__device__ __forceinline__ int at_sw(int row, int chunk) { return row * 128 + ((chunk ^ (row & 7)) << 4); }

template <int TYPE>
__device__ __forceinline__ void attn_unit(Frame& F, int b, int hh, int qb) {
    LAS unsigned char* lds = F.lds;
    const int tid = F.tid, lane = F.lane, w = F.wave, r = lane & 31, hf = lane >> 5;
    const bf16_t* qk = (const bf16_t*)(F.ws + WS_QK); const bf16_t* vt = (const bf16_t*)(F.ws + WS_VT); bf16_t* o = (bf16_t*)(F.ws + WS_O);
    const float* fcum = (const float*)(F.ws + WS_FCUM) + (size_t)(b * 8 + hh) * SEQ;
    const int qcol = (TYPE == 0 ? 0 : 1536) + hh * 64, kcol = (TYPE == 0 ? 512 : 2048) + hh * 64, hg = TYPE * 8 + hh;
    const int q0 = qb * 256, qrow = q0 + 32 * w + r;
    const size_t tok0 = (size_t)b * SEQ;
    bf16x8 qf[4];
#pragma unroll
    for (int s = 0; s < 4; ++s) qf[s] = *(const GAS bf16x8*)(qk + (tok0 + qrow) * NQKV + qcol + 16 * s + 8 * hf);
    const float fq2 = TYPE == 0 ? fcum[qrow] : 0.f;
    const int srow = tid >> 3, sch = tid & 7;
    const bf16_t* kg = qk + (tok0 + srow) * NQKV + kcol + 8 * sch;
    const bf16_t* vg = vt + ((size_t)((b * 16 + hg) * 64 + srow)) * SEQ + 8 * sch;
    const int sdst = at_sw(srow, sch);
    const int ntiles = 4 * (qb + 1), jw = 4 * qb + (w >> 1);
    const int pir = (r & 0x13) | ((r & 4) << 1) | ((r & 8) >> 1);
    bf16x8 tneg[2];
    if (TYPE == 1) {
#pragma unroll
        for (int s2 = 0; s2 < 2; ++s2)
#pragma unroll
            for (int j = 0; j < 8; ++j) tneg[s2][j] = (16 * s2 + 8 * hf + j > pir) ? (short)0xBF80 : (short)0;
    }
    f32x16 oacc[2];
#pragma unroll
    for (int i = 0; i < 16; ++i) { oacc[0][i] = 0.f; oacc[1][i] = 0.f; }
    float mrun = -1e30f, lrun = 0.f, Rrun = 0.f;

    const int jfirst = TYPE == 0 ? 0 : ntiles - 1, jstep = TYPE == 0 ? 1 : -1;
    { const int j = jfirst; const u32x4 kv = *(const GAS u32x4*)(kg + (size_t)64 * j * NQKV), vv = *(const GAS u32x4*)(vg + 64 * j);
      *(LAS u32x4*)(lds + AT_K + sdst) = kv; *(LAS u32x4*)(lds + AT_V + sdst) = vv;
      if (TYPE == 0 && tid < 64) *(LAS float*)(lds + AT_F + tid * 4) = fcum[64 * j + tid]; }
    __syncthreads();
    for (int it = 0; it < ntiles; ++it) {
        const int j = jfirst + it * jstep, cur = it & 1, nb = cur ^ 1;
        const bool more = it + 1 < ntiles;
        u32x4 kvn, vvn; float fn = 0.f;
        if (more) { const int jn = j + jstep; kvn = *(const GAS u32x4*)(kg + (size_t)64 * jn * NQKV); vvn = *(const GAS u32x4*)(vg + 64 * jn); if (TYPE == 0 && tid < 64) fn = fcum[64 * jn + tid]; }
        if (j <= jw) {
            LAS unsigned char* kt = lds + AT_K + cur * AT_TILE; LAS unsigned char* vtl = lds + AT_V + cur * AT_TILE; const LAS float* ft = (const LAS float*)(lds + AT_F + cur * 256);
            const bool diag = (j == jw);
#pragma unroll
            for (int kb0 = 0; kb0 < 2; ++kb0) {
                const int kb = TYPE == 0 ? kb0 : 1 - kb0;
                const bool skip = diag && ((w & 1) == 0) && kb == 1;
                if (!skip) {
                    const bool mask = diag && (((w & 1) == 0) ? (kb == 0) : (kb == 1));
                    f32x16 s;
#pragma unroll
                    for (int i = 0; i < 16; ++i) s[i] = 0.f;
#pragma unroll
                    for (int st = 0; st < 4; ++st) { const bf16x8 kf = *(const LAS bf16x8*)(kt + at_sw(32 * kb + pir, 2 * st + hf)); s = __builtin_amdgcn_mfma_f32_32x32x16_bf16(kf, qf[st], s, 0, 0, 0); }
                    bf16x8 pf[2];
                    if (TYPE == 0) {
                        f32x4 fk[4];
#pragma unroll
                        for (int g = 0; g < 2; ++g) { fk[2 * g] = *(const LAS f32x4*)(ft + 32 * kb + 16 * g + 8 * hf); fk[2 * g + 1] = *(const LAS f32x4*)(ft + 32 * kb + 16 * g + 8 * hf + 4); }
                        float mx = -1e30f;
#pragma unroll
                        for (int i = 0; i < 16; ++i) { float v = s[i] + (fq2 - fk[i >> 2][i & 3]); if (mask && (16 * (i >> 3) + 8 * hf + (i & 7) > r)) v = -1e30f; s[i] = v; mx = fmaxf(mx, v); }
                        mx = fmaxf(mx, __shfl_xor(mx, 32));
                        if (__any(mx > mrun + 4.0f)) { const float mn = fmaxf(mrun, mx), al = __builtin_amdgcn_exp2f(mrun - mn); mrun = mn; lrun *= al;
#pragma unroll
                            for (int i = 0; i < 16; ++i) { oacc[0][i] *= al; oacc[1][i] *= al; } }
                        float ps = 0.f;
#pragma unroll
                        for (int i = 0; i < 16; ++i) { const float p = __builtin_amdgcn_exp2f(s[i] - mrun); s[i] = p; ps += p; }
                        lrun += ps;
                    } else {
                        float ls = 0.f; f32x16 cin; unsigned lp[8];
#pragma unroll
                        for (int i = 0; i < 16; ++i) { const float z = s[i]; float L = z > 30.f ? z : __builtin_amdgcn_logf(1.f + __builtin_amdgcn_exp2f(z));
                            const bool valid = !(mask && (16 * (i >> 3) + 8 * hf + (i & 7) >= r));
                            L = valid ? L : 0.f; ls += L; cin[i] = z - L - Rrun; s[i] = L; }
#pragma unroll
                        for (int i = 0; i < 8; ++i) lp[i] = cvt_pk_bf16(s[2 * i], s[2 * i + 1]);
                        bf16x8 lf0, lf1; { u32x4 t0 = {lp[0], lp[1], lp[2], lp[3]}, t1 = {lp[4], lp[5], lp[6], lp[7]}; lf0 = __builtin_bit_cast(bf16x8, t0); lf1 = __builtin_bit_cast(bf16x8, t1); }
#if defined(DBG_VALU_CUM)
                        {
                          float G0 = 0.f, G1 = 0.f;
#pragma unroll
                          for (int i = 0; i < 8; ++i) { G0 += s[i]; G1 += s[8 + i]; }
                          const float PG0 = __shfl_xor(G0, 32), PG1 = __shfl_xor(G1, 32);
                          const float later0 = (hf == 0 ? PG0 : 0.f) + G1 + PG1;
                          const float later1 = (hf == 0 ? PG1 : 0.f);
                          float run = 0.f;
#pragma unroll
                          for (int i = 7; i >= 0; --i) { cin[i] -= run + later0; run += s[i]; }
                          run = 0.f;
#pragma unroll
                          for (int i = 15; i >= 8; --i) { cin[i] -= run + later1; run += s[i]; } }
                        asm volatile("" :: "v"(lf0), "v"(lf1));
#else
                        cin = __builtin_amdgcn_mfma_f32_32x32x16_bf16(tneg[0], lf0, cin, 0, 0, 0);
                        cin = __builtin_amdgcn_mfma_f32_32x32x16_bf16(tneg[1], lf1, cin, 0, 0, 0);
#endif
#pragma unroll
                        for (int i = 0; i < 16; ++i) { const bool valid = !(mask && (16 * (i >> 3) + 8 * hf + (i & 7) >= r)); s[i] = valid ? __builtin_amdgcn_exp2f(cin[i]) : 0.f; }
                        ls += __shfl_xor(ls, 32); Rrun += ls;
                    }
                    { unsigned pp[8];
#pragma unroll
                      for (int i = 0; i < 8; ++i) pp[i] = cvt_pk_bf16(s[2 * i], s[2 * i + 1]);
                      u32x4 t0 = {pp[0], pp[1], pp[2], pp[3]}, t1 = {pp[4], pp[5], pp[6], pp[7]}; pf[0] = __builtin_bit_cast(bf16x8, t0); pf[1] = __builtin_bit_cast(bf16x8, t1); }
#pragma unroll
                    for (int dt = 0; dt < 2; ++dt)
#pragma unroll
                        for (int s2 = 0; s2 < 2; ++s2) { const bf16x8 vf = *(const LAS bf16x8*)(vtl + at_sw(32 * dt + r, 4 * kb + 2 * s2 + hf)); oacc[dt] = __builtin_amdgcn_mfma_f32_32x32x16_bf16(vf, pf[s2], oacc[dt], 0, 0, 0); }
                }
            }
        }
        if (more) { *(LAS u32x4*)(lds + AT_K + nb * AT_TILE + sdst) = kvn; *(LAS u32x4*)(lds + AT_V + nb * AT_TILE + sdst) = vvn; if (TYPE == 0 && tid < 64) *(LAS float*)(lds + AT_F + nb * 256 + tid * 4) = fn; }
        __syncthreads();
    }
    float inv = 1.f;
    if (TYPE == 0) { const float lt = lrun + __shfl_xor(lrun, 32); inv = 1.f / lt; }
    float ss = 0.f;
#pragma unroll
    for (int dt = 0; dt < 2; ++dt)
#pragma unroll
        for (int i = 0; i < 16; ++i) { const float v = oacc[dt][i] * inv; oacc[dt][i] = v; ss += v * v; }
    ss += __shfl_xor(ss, 32);
    float rs = 1.0f / sqrtf(ss * (1.f / 64.f) + RMS_EPS);
#if defined(DBG_ZERO_SB)
    if (TYPE == 1) rs = 0.f;
#endif
#if defined(DBG_ZERO_FOX)
    if (TYPE == 0) rs = 0.f;
#endif
    const float* g = (TYPE == 0 ? F.in[I_FOXG] : F.in[I_SBG]) + hh * 64;
    bf16_t* orow = o + (tok0 + qrow) * DM + hg * 64;
#pragma unroll
    for (int dt = 0; dt < 2; ++dt)
#pragma unroll
        for (int q = 0; q < 4; ++q) { const int d = 32 * dt + 8 * q + 4 * hf; const f32x4 gv = *(const GAS f32x4*)(g + d);
            u32x2 wv; wv.x = cvt_pk_bf16(oacc[dt][4 * q] * rs * gv[0], oacc[dt][4 * q + 1] * rs * gv[1]); wv.y = cvt_pk_bf16(oacc[dt][4 * q + 2] * rs * gv[2], oacc[dt][4 * q + 3] * rs * gv[3]);
            *(GAS u32x2*)(orow + d) = wv; }
}

__device__ __forceinline__ void phase_attn(Frame& F) {
    for (int p = F.vcu; p < 512; p += F.G) {
        const int type = p >> 8, combo = (p & 255) >> 3, qp = p & 7, b = combo >> 3, hh = combo & 7;
        if (type == 0) { attn_unit<0>(F, b, hh, 15 - qp); attn_unit<0>(F, b, hh, qp); }
        else { attn_unit<1>(F, b, hh, 15 - qp); attn_unit<1>(F, b, hh, qp); }
    }
}

__device__ __forceinline__ void phase5(Frame& F) {
    const int gw = F.vcu * NWAVES + F.wave, NGW = F.G * NWAVES;
    float* x1 = (float*)(F.ws + WS_X1); bf16_t* u2 = (bf16_t*)(F.ws + WS_U2); const float* ada = (const float*)(F.ws + WS_ADA);
    const float* g1 = F.in[I_LN1G]; const float* b1 = F.in[I_LN1B];
    for (int m = gw; m < NTOK; m += NGW) {
        const int b = m >> 12; f32x4 v[4]; float s = 0.f;
#pragma unroll
        for (int j = 0; j < 4; ++j) { v[j] = *(const GAS f32x4*)(x1 + (size_t)m * DM + 4 * F.lane + 256 * j); s += (v[j][0] + v[j][1]) + (v[j][2] + v[j][3]); }
        const float mean = wave_sum(s) * (1.f / DM); float s2 = 0.f;
#pragma unroll
        for (int j = 0; j < 4; ++j) { v[j] = v[j] - mean; s2 += (v[j][0] * v[j][0] + v[j][1] * v[j][1]) + (v[j][2] * v[j][2] + v[j][3] * v[j][3]); }
        const float rstd = 1.f / sqrtf(wave_sum(s2) * (1.f / DM) + LN_EPS);
#pragma unroll
        for (int j = 0; j < 4; ++j) { const int d = 4 * F.lane + 256 * j;
            const f32x4 gg = *(const GAS f32x4*)(g1 + d), bb = *(const GAS f32x4*)(b1 + d);
            const f32x4 xo = v[j] * rstd * gg + bb; *(GAS f32x4*)(x1 + (size_t)m * DM + d) = xo;
            const f32x4 sc = *(const GAS f32x4*)(ada + b * 6144 + 4096 + d) + 1.0f, sh = *(const GAS f32x4*)(ada + b * 6144 + 3072 + d);
            const f32x4 u = xo * sc + sh;
            unsigned hb[4]; float lo[4];
#pragma unroll
            for (int q = 0; q < 4; ++q) { hb[q] = f2bf(u[q]); lo[q] = u[q] - bf2f(hb[q]); }
            u32x2 wh, wl; wh.x = hb[0] | (hb[1] << 16); wh.y = hb[2] | (hb[3] << 16); wl.x = pk2(lo[0], lo[1]); wl.y = pk2(lo[2], lo[3]);
            *(GAS u32x2*)(u2 + (size_t)m * 2048 + d) = wh; *(GAS u32x2*)(u2 + (size_t)m * 2048 + 1024 + d) = wl; }
    }
}

__device__ __forceinline__ void phase7(Frame& F) {
    const int gw = F.vcu * NWAVES + F.wave, NGW = F.G * NWAVES, lane = F.lane;
    const float* lg = (const float*)(F.ws + WS_LOG); const float* rb = F.in[I_RB];
    unsigned* cnt = (unsigned*)(F.ws + WS_CTL) + CW_CNT; int* list = (int*)(F.ws + WS_LIST); float* topw = (float*)(F.ws + WS_TOPW);
    const f32x4 bias = *(const GAS f32x4*)(rb + 4 * lane);
    for (int t = gw; t < NTOK; t += NGW) {
        const size_t off = (size_t)t * NEXP + 4 * lane;
        const f32x4 l0 = *(const GAS f32x4*)(lg + off), l1 = *(const GAS f32x4*)(lg + (size_t)NTOK * NEXP + off), l2 = *(const GAS f32x4*)(lg + 2 * (size_t)NTOK * NEXP + off);
        float sc[4], sel[4];
#pragma unroll
        for (int i = 0; i < 4; ++i) { const float z = (l0[i] + l1[i]) + l2[i]; sc[i] = 1.f / (1.f + expf(-z)); sel[i] = sc[i] + bias[i]; }
        float a1 = fmaxf(sel[0], sel[1]), a2 = fminf(sel[0], sel[1]);
        { const float c1 = fmaxf(sel[2], sel[3]), c2 = fminf(sel[2], sel[3]); const float n1 = fmaxf(a1, c1), n2 = fmaxf(fminf(a1, c1), fmaxf(a2, c2)); a1 = n1; a2 = n2; }
#pragma unroll
        for (int o = 1; o < 8; o <<= 1) { const float b1v = __shfl_xor(a1, o), b2v = __shfl_xor(a2, o); const float n1 = fmaxf(a1, b1v), n2 = fmaxf(fminf(a1, b1v), fmaxf(a2, b2v)); a1 = n1; a2 = n2; }
        const float gs = a1 + a2; const int g = lane >> 3; int rank = 0;
#pragma unroll
        for (int gg = 0; gg < 8; ++gg) { const float o = __shfl(gs, gg * 8); rank += (o > gs || (o == gs && gg < g)) ? 1 : 0; }
        const bool gsel = rank < 4;
        float cand[4];
#pragma unroll
        for (int i = 0; i < 4; ++i) cand[i] = gsel ? sel[i] : -INFINITY;
        int my_e = 0; float my_w = 0.f, wsum = 0.f;
#pragma unroll
        for (int k = 0; k < TOPK; ++k) {
            float bv = cand[0]; int bi = 4 * lane;
#pragma unroll
            for (int i = 1; i < 4; ++i) if (cand[i] > bv) { bv = cand[i]; bi = 4 * lane + i; }
#pragma unroll
            for (int o = 32; o >= 1; o >>= 1) { const float ov = __shfl_xor(bv, o); const int oi = __shfl_xor(bi, o); if (ov > bv || (ov == bv && oi < bi)) { bv = ov; bi = oi; } }
            const int wl = bi >> 2, wi = bi & 3;
            float scw = sc[0]; scw = wi == 1 ? sc[1] : scw; scw = wi == 2 ? sc[2] : scw; scw = wi == 3 ? sc[3] : scw;
            scw = __shfl(scw, wl);
            if (lane == wl) {
#pragma unroll
                for (int i = 0; i < 4; ++i) if (i == wi) cand[i] = -INFINITY; }
            wsum += scw;
            if (lane == k) { my_e = bi; my_w = scw; }
        }
        if (lane < TOPK) { const int a = t * TOPK + lane; topw[a] = my_w / wsum * ROUTED_SCALE;
            const unsigned pos = atomicAdd(&cnt[my_e], 1u); list[(size_t)my_e * LIST_CAP + pos] = a; }
    }
}

__device__ __forceinline__ int build_tile_table(Frame& F) {
    LAS int* ts = (LAS int*)(F.lds + TS_OFF); const unsigned* cnt = (const unsigned*)(F.ws + WS_CTL) + CW_CNT;
    __syncthreads();
    if (F.tid == 0) { int a = 0; for (int e = 0; e < NEXP; ++e) { ts[e] = a; a += ((int)__hip_atomic_load(cnt + e, RLX_AGENT) + 255) >> 8; } ts[NEXP] = a; }
    __syncthreads();
    return ts[NEXP];
}

__device__ __forceinline__ void phase10(Frame& F) {
    const int gw = F.vcu * NWAVES + F.wave, NGW = F.G * NWAVES;
    const float* x1 = (const float*)(F.ws + WS_X1); const bf16_t* y = (const bf16_t*)(F.ws + WS_Y); const bf16_t* ys = (const bf16_t*)(F.ws + WS_YS); const float* ada = (const float*)(F.ws + WS_ADA);
    const float* g2 = F.in[I_LN2G]; const float* b2 = F.in[I_LN2B];
    for (int m = gw; m < NTOK; m += NGW) {
        const int b = m >> 12; f32x4 v[4]; float s = 0.f;
#pragma unroll
        for (int j = 0; j < 4; ++j) { const int d = 4 * F.lane + 256 * j;
            const u32x2 sv = *(const GAS u32x2*)(ys + (size_t)m * DM + d);
            f32x4 f = {bf2f(sv.x & 0xffffu), bf2f(sv.x >> 16), bf2f(sv.y & 0xffffu), bf2f(sv.y >> 16)};
#pragma unroll
            for (int k = 0; k < TOPK; ++k) { const u32x2 yv = *(const GAS u32x2*)(y + ((size_t)m * TOPK + k) * DM + d);
                f[0] += bf2f(yv.x & 0xffffu); f[1] += bf2f(yv.x >> 16); f[2] += bf2f(yv.y & 0xffffu); f[3] += bf2f(yv.y >> 16); }
            const f32x4 xv = *(const GAS f32x4*)(x1 + (size_t)m * DM + d), gv = *(const GAS f32x4*)(ada + b * 6144 + 5120 + d) + 1.0f;
            v[j] = xv * ALPHA + gv * f; s += (v[j][0] + v[j][1]) + (v[j][2] + v[j][3]); }
        const float mean = wave_sum(s) * (1.f / DM); float s2 = 0.f;
#pragma unroll
        for (int j = 0; j < 4; ++j) { v[j] = v[j] - mean; s2 += (v[j][0] * v[j][0] + v[j][1] * v[j][1]) + (v[j][2] * v[j][2] + v[j][3] * v[j][3]); }
        const float rstd = 1.f / sqrtf(wave_sum(s2) * (1.f / DM) + LN_EPS);
#pragma unroll
        for (int j = 0; j < 4; ++j) { const int d = 4 * F.lane + 256 * j; const f32x4 gg = *(const GAS f32x4*)(g2 + d), bb = *(const GAS f32x4*)(b2 + d);
            *(GAS f32x4*)(F.out + (size_t)m * DM + d) = v[j] * rstd * gg + bb; }
    }
}

__global__ void __launch_bounds__(NTHR, 2) fwd_kernel(Args args) {
    extern __shared__ __attribute__((aligned(16))) unsigned char lds_raw[];
    Frame F;
    F.lds = (LAS unsigned char*)lds_raw; F.ws = args.ws; F.in = args.in; F.out = args.out;
    F.tid = threadIdx.x; F.lane = F.tid & 63; F.wave = __builtin_amdgcn_readfirstlane(F.tid >> 6);
    F.G = gridDim.x; F.bx = blockIdx.x; F.vcu = (F.G % 8 == 0) ? (F.bx % 8) * (F.G / 8) + F.bx / 8 : F.bx;
    volatile LAS unsigned* MISC = (volatile LAS unsigned*)(F.lds + LDSCTL_OFF);
    for (int u = F.tid; u < 64; u += NTHR) MISC[u] = 0u;
    __syncthreads();
    unsigned* ctl = (unsigned*)(F.ws + WS_CTL);
    XcdBarrier bar = xcd_barrier_post(ctl + CW_BAR, MISC + 8);
    unsigned char* ws = F.ws;

    phase0(F);
    xcd_barrier(bar);
    phase1(F);
    xcd_barrier(bar);
    if (F.bx < 32) fcum_block(F, F.bx);
    __syncthreads();
    { ProbQK p; p.A = (const char*)(ws + WS_U1); p.B = (const char*)(ws + WS_WIN); p.K = DM; p.lda = 2048; p.ldb = 2048; p.G = F.G; p.c = F.bx; p.qk = (bf16_t*)(ws + WS_QK); pg8::gemm_phase(F.lds, p); }
    { ProbVT p; p.A = (const char*)(ws + WS_U1); p.B = (const char*)(ws + WS_WIN); p.K = DM; p.lda = 2048; p.ldb = 2048; p.G = F.G; p.c = F.bx; p.vt = (bf16_t*)(ws + WS_VT); pg8::gemm_phase(F.lds, p); }
    xcd_barrier(bar);
    phase_attn(F);
    xcd_barrier(bar);
    { ProbZ p; p.A = (const char*)(ws + WS_O); p.B = (const char*)(ws + WS_WOUT); p.K = DM; p.lda = 2048; p.ldb = 2048; p.G = F.G; p.c = F.bx; p.x = F.in[I_X]; p.ada = (const float*)(ws + WS_ADA); p.z = (float*)(ws + WS_X1); pg8::gemm_phase(F.lds, p); }
    xcd_barrier(bar);
    phase5(F);
    xcd_barrier(bar);
#if defined(DBG_STOP5)
    { const f32x4* src = (const f32x4*)(ws + WS_X1); f32x4* dst = (f32x4*)F.out;
      for (size_t i = (size_t)F.bx * NTHR + F.tid; i < (size_t)NTOK * DM / 4; i += (size_t)F.G * NTHR) dst[i] = src[i]; }
    return;
#endif
    { ProbP6 p; p.A = (const char*)(ws + WS_U2); p.B = (const char*)(ws + WS_WR); p.K = DM; p.lda = 4096; p.ldb = 2048; p.G = F.G; p.c = F.vcu; p.logits = (float*)(ws + WS_LOG); p.hs = (bf16_t*)(ws + WS_HS); pg8::gemm_phase(F.lds, p); }
    xcd_barrier(bar);
    phase7(F);
    xcd_barrier(bar);
    const int NT = build_tile_table(F);
    ExpTab T; T.ts = (const LAS int*)(F.lds + TS_OFF); T.NT = NT; T.cnt = (const unsigned*)(ws + WS_CTL) + CW_CNT; T.list = (const int*)(ws + WS_LIST);
    { ProbP8 p; p.A = (const char*)(ws + WS_U2); p.B = (const char*)(ws + WS_WGU); p.K = DM; p.lda = 4096; p.ldb = 2048; p.G = F.G; p.c = F.vcu; p.T = T; p.h = (bf16_t*)(ws + WS_H); pg8::gemm_phase(F.lds, p); }
    xcd_barrier(bar);
    { ProbP9 p; p.A = (const char*)(ws + WS_HS); p.B = (const char*)(ws + WS_WSD); p.K = DEXP; p.lda = 512; p.ldb = 512; p.G = F.G; p.c = F.vcu; p.T = T; p.topw = (const float*)(ws + WS_TOPW); p.y = (bf16_t*)(ws + WS_Y); p.ys = (bf16_t*)(ws + WS_YS); pg8::gemm_phase(F.lds, p); }
    xcd_barrier(bar);
    phase10(F);
}

extern "C" void kernel_launch(void* const* d_in, const int* in_sizes, int n_in, void* d_out, int out_size, void* d_ws, size_t ws_size, hipStream_t stream) {
    static int grid = 0;
    if (grid == 0) {
        if (n_in != 21 || out_size != NTOK * DM || ws_size < WS_END) { fprintf(stderr, "kernel_launch: unexpected shapes (n_in %d out %d ws %zu)\n", n_in, out_size, ws_size); grid = -1; return; }
        int dev = 0, cus = 0, per_cu = 0;
        hipGetDevice(&dev); hipDeviceGetAttribute(&cus, hipDeviceAttributeMultiprocessorCount, dev);
        hipFuncSetAttribute((const void*)fwd_kernel, hipFuncAttributeMaxDynamicSharedMemorySize, LDS_BYTES);
        hipOccupancyMaxActiveBlocksPerMultiprocessor(&per_cu, (const void*)fwd_kernel, NTHR, LDS_BYTES);
        (void)hipGetLastError();
        if (per_cu < 1) { fprintf(stderr, "kernel_launch: occupancy query says %d blocks/CU\n", per_cu); }
        grid = cus < 256 ? cus : 256;
        grid -= grid % 8;
    }
    if (grid <= 0) return;
    hipMemsetAsync((char*)d_ws + WS_CTL, 0, CTL_ZERO_BYTES, stream);
    Args a{};
    for (int i = 0; i < 21; ++i) a.in[i] = (const float*)d_in[i];
    a.out = (float*)d_out; a.ws = (unsigned char*)d_ws;
    void* kargs[] = {&a};
    hipError_t e = hipLaunchCooperativeKernel((const void*)fwd_kernel, dim3(grid), dim3(NTHR), kargs, LDS_BYTES, stream);
    if (e != hipSuccess) fprintf(stderr, "kernel_launch: cooperative launch failed: %s (grid %d)\n", hipGetErrorString(e), grid);
}
```

```cpp
#define DBG_VALU_CUM 1
#include <hip/hip_runtime.h>
#include <cstdio>
#include <cstdint>

#define LAS __attribute__((address_space(3)))
#define GAS __attribute__((address_space(1)))
typedef unsigned short bf16_t;
typedef short bf16x8 __attribute__((ext_vector_type(8)));
typedef float f32x4 __attribute__((ext_vector_type(4)));
typedef float f32x16 __attribute__((ext_vector_type(16)));
typedef unsigned u32x4 __attribute__((ext_vector_type(4)));
typedef unsigned u32x2 __attribute__((ext_vector_type(2)));

constexpr int DM = 1024, NB = 4, SEQ = 4096, NTOK = NB * SEQ;
constexpr int NQKV = 3072, DIN = 3080, NEXP = 256, TOPK = 8, DEXP = 256;
constexpr float ALPHA = 1.189207115002721f;
constexpr float LN_EPS = 1e-5f, RMS_EPS = 1e-6f, ROUTED_SCALE = 2.5f;
constexpr float LOG2E = 1.4426950408889634f;
constexpr float QSCALE = 0.125f * LOG2E;
constexpr int LIST_CAP = NTOK;

constexpr size_t MiB = 1u << 20;
constexpr size_t WS_CTL = 0, CTL_ZERO_BYTES = 256 * 1024;
constexpr size_t WS_ADA = 1 * MiB;
constexpr size_t WS_WF = WS_ADA + 128 * 1024;
constexpr size_t WS_ADAP = 14 * MiB + 512 * 1024;
constexpr size_t WS_LOGF = 2 * MiB;
constexpr size_t WS_FCUM = WS_LOGF + 512 * 1024;
constexpr size_t WS_WIN = 3 * MiB;
constexpr size_t WS_WOUT = 9 * MiB;
constexpr size_t WS_WR = 11 * MiB;
constexpr size_t WS_WSGU = 12 * MiB;
constexpr size_t WS_WSD = 13 * MiB;
constexpr size_t WS_TOPW = 14 * MiB;
constexpr size_t WS_APOS = 15 * MiB + 512 * 1024;
constexpr size_t WS_X1 = 16 * MiB;
constexpr size_t WS_U2 = 80 * MiB;
constexpr size_t WS_HS = 144 * MiB;
constexpr size_t WS_LIST = 152 * MiB;
constexpr size_t WS_H = 176 * MiB;
constexpr size_t WS_YS = 280 * MiB;
constexpr size_t WS_Y = 312 * MiB;
constexpr size_t WS_U1 = 312 * MiB;
constexpr size_t WS_QK = 344 * MiB;
constexpr size_t WS_VT = 440 * MiB;
constexpr size_t WS_O = 472 * MiB;
constexpr size_t WS_LOG = 504 * MiB;
constexpr size_t WS_WGU = 568 * MiB;
constexpr size_t WS_WD = 824 * MiB;
constexpr size_t WS_END = 952 * MiB;
constexpr int CW_CNT = 1024;
constexpr int CW_BAR = 4096;

constexpr int RING_BYTES = 131072;
constexpr int LDSCTL_OFF = RING_BYTES;
constexpr int TS_OFF = RING_BYTES + 256;
constexpr int LDS_BYTES = 147456;
constexpr int NWAVES = 8, NTHR = 512;

#define RLX_AGENT __ATOMIC_RELAXED, __HIP_MEMORY_SCOPE_AGENT
#define LDS_WAIT() asm volatile("s_waitcnt lgkmcnt(0)" ::: "memory")
#define VM_WAIT() asm volatile("s_waitcnt vmcnt(0)" ::: "memory")
__device__ __forceinline__ unsigned f2bf(float f) { unsigned u = __builtin_bit_cast(unsigned, f); return (u + 0x7fffu + ((u >> 16) & 1u)) >> 16; }
__device__ __forceinline__ unsigned pk2(float lo, float hi) { return f2bf(lo) | (f2bf(hi) << 16); }
__device__ __forceinline__ float bf2f(unsigned h) { return __builtin_bit_cast(float, h << 16); }
__device__ __forceinline__ unsigned cvt_pk_bf16(float lo, float hi) { unsigned r; asm volatile("v_cvt_pk_bf16_f32 %0, %1, %2" : "=v"(r) : "v"(lo), "v"(hi)); return r; }
__device__ __forceinline__ float wave_sum(float v) {
#pragma unroll
    for (int o = 1; o < 64; o <<= 1) v += __shfl_xor(v, o);
    return v;
}

#define XB_TMO      128
#define XB_XCNT(j)  (256  + 64 * (j))
#define XB_XSUB(j)  (1280 + 64 * (j))
#define XB_XGEN(j)  (2304 + 64 * (j))
#define XB_TOP      3328
#define XB_TOPGEN   3392
#define XCD_BAR_WORDS 3456
#define XB_SPIN_CAP (1u << 18)
__device__ __forceinline__ unsigned xb_ld(unsigned* p)              { return __hip_atomic_load(p, __ATOMIC_RELAXED, __HIP_MEMORY_SCOPE_AGENT); }
__device__ __forceinline__ unsigned xb_add(unsigned* p, unsigned v) { return __hip_atomic_fetch_add(p, v, __ATOMIC_RELAXED, __HIP_MEMORY_SCOPE_AGENT); }
__device__ __forceinline__ unsigned xb_xcc_id() { return (unsigned)__builtin_amdgcn_s_getreg((3 << 11) | 20) & 0xFu; }
#define XB_SPIN(cond, bar) do { unsigned _sp = 0; while (cond) { __builtin_amdgcn_s_sleep(1); \
    if ((++_sp & 255u) == 0u) { if (xb_ld(&(bar)[XB_TMO])) break; if (_sp > XB_SPIN_CAP) { atomicAdd(&(bar)[XB_TMO], 1u); break; } } } } while (0)
struct XcdBarrier { unsigned* bar; unsigned x; volatile LAS unsigned* st; };
__device__ __forceinline__ XcdBarrier xcd_barrier_post(unsigned* bar, volatile LAS unsigned* st) {
    XcdBarrier b; b.bar = bar; b.x = xb_xcc_id(); b.st = st;
    if (threadIdx.x == 0) (void)xb_add(&bar[XB_XCNT(b.x)], 1u);
    return b;
}
__device__ __forceinline__ void xcd_barrier_complete(unsigned* bar, unsigned x, unsigned& nloc, unsigned& nx) {
    const unsigned G = gridDim.x * gridDim.y * gridDim.z;
    unsigned sum, cnt, mine, sp = 0u;
    for (;;) {
        sum = 0u; cnt = 0u; mine = 0u;
#pragma unroll
        for (unsigned j = 0; j < 16; ++j) { const unsigned c = xb_ld(&bar[XB_XCNT(j)]); sum += c; cnt += (c > 0u) ? 1u : 0u; mine = (j == x) ? c : mine; }
        if (sum == G) break;
        __builtin_amdgcn_s_sleep(1);
        if ((++sp & 255u) == 0u) { if (xb_ld(&bar[XB_TMO])) break; if (sp > XB_SPIN_CAP) { atomicAdd(&bar[XB_TMO], 1u); break; } }
    }
    nloc = mine > 0u ? mine : 1u; nx = cnt > 0u ? cnt : 1u;
}
__device__ __forceinline__ void xcd_barrier(const XcdBarrier& b) {
    asm volatile("s_waitcnt vmcnt(0)" ::: "memory");
    __syncthreads();
    if (threadIdx.x == 0) {
        unsigned* bar = b.bar;
        __builtin_amdgcn_s_waitcnt(0);
        unsigned nloc = b.st[0], nx = b.st[1];
        if (nloc == 0u) { xcd_barrier_complete(bar, b.x, nloc, nx); b.st[0] = nloc; b.st[1] = nx; }
        const unsigned old = xb_add(&bar[XB_XSUB(b.x)], 1u);
        const unsigned gen = old / nloc;
        if (old + 1u == (gen + 1u) * nloc) {
            __builtin_amdgcn_fence(__ATOMIC_RELEASE, "agent");
            asm volatile("s_waitcnt vmcnt(0)" ::: "memory");
            const unsigned og = xb_add(&bar[XB_TOP], 1u);
            const unsigned tg = og / nx;
            if (og + 1u == (tg + 1u) * nx) xb_add(&bar[XB_TOPGEN], 1u);
            else XB_SPIN(xb_ld(&bar[XB_TOPGEN]) == tg, bar);
            __builtin_amdgcn_fence(__ATOMIC_ACQUIRE, "agent");
            xb_add(&bar[XB_XGEN(b.x)], 1u);
            asm volatile("s_waitcnt vmcnt(0)" ::: "memory");
        } else {
            XB_SPIN(xb_ld(&bar[XB_XGEN(b.x)]) == gen, bar);
            __builtin_amdgcn_fence(__ATOMIC_ACQUIRE, "agent");
            asm volatile("s_waitcnt vmcnt(0)" ::: "memory");
        }
    }
    __syncthreads();
}

namespace pg8 {
constexpr int BM = 256, BK = 64, HALF = 128, HTB = HALF * BK * 2, STAGE_BYTES = 8 * HTB;
__device__ __forceinline__ int lds_byte(int r, int c) { const int st = (r >> 4) * 2 + (c >> 5), rr = r & 15, cc = c & 31, ob = rr * 64 + cc * 2; return st * 1024 + (ob ^ (((ob >> 9) & 1) << 5)); }
__device__ __forceinline__ void stage_rc(int b, int& R, int& C) { const int st = b / 1024, sb = b % 1024, swz = sb ^ (((sb >> 9) & 1) << 5); R = (st >> 1) * 16 + swz / 64; C = (st & 1) * 32 + (swz % 64) / 2; }
__device__ __forceinline__ int perm32(int rho) { const int n = rho >> 4, i = rho & 15; return 8 * (i >> 2) + 4 * n + (i & 3); }

struct Unit { int pm, pn, e, cnt; };

template <class P>
__device__ __forceinline__ void gemm_phase(LAS unsigned char* lds, const P& prob) {
    int tid_ = threadIdx.x; asm volatile("" : "+v"(tid_));
    const int tid = tid_, wid = __builtin_amdgcn_readfirstlane(tid >> 6), lane = tid & 63, wr = wid >> 2, wc = wid & 3, fr = lane & 15, fq = lane >> 4;
    const int nt = prob.K / BK;
    int Rr[2]; unsigned voffA[2], voffB[2];
#pragma unroll
    for (int i = 0; i < 2; ++i) { int R, C; stage_rc(tid * 16 + i * 8192, R, C); Rr[i] = R; const int Rb = P::PERM ? ((R & ~31) + perm32(R & 31)) : R;
        voffA[i] = P::GATHER ? (unsigned)(C * 2) : (unsigned)(R * prob.lda + C * 2); voffB[i] = (unsigned)(Rb * prob.ldb + C * 2); }
    const size_t kstep = (size_t)(BK * 2);
    const size_t hA = P::GATHER ? 0 : (size_t)HALF * prob.lda, hB = (size_t)HALF * prob.ldb;
    const unsigned ldsw = (unsigned)wid * 1024u;
    const int aoff = lds_byte(wr * 64 + fr, fq * 8), boff = lds_byte(wc * 32 + fr, fq * 8);
#define PG8_SA(b, h) (((b) * 2 + (h)) * HTB)
#define PG8_SB(b, h) ((4 + (b) * 2 + (h)) * HTB)
#define PG8_STAGE(bufoff, gbase, voff) do { _Pragma("unroll") for (int _i = 0; _i < 2; ++_i) \
        __builtin_amdgcn_global_load_lds((const unsigned*)((const char*)(gbase) + (voff)[_i]), (LAS unsigned*)(lds + (bufoff) + ldsw + _i * 8192), 16, 0, 0); } while (0)
#define PG8_LDA(dst, b, h) do { _Pragma("unroll") for (int m = 0; m < 4; ++m) _Pragma("unroll") for (int k = 0; k < 2; ++k) dst[m][k] = *(const LAS bf16x8*)(lds + PG8_SA(b, h) + aoff + m * 2048 + k * 1024); } while (0)
#define PG8_LDB(dst, b, h) do { _Pragma("unroll") for (int n = 0; n < 2; ++n) _Pragma("unroll") for (int k = 0; k < 2; ++k) dst[n][k] = *(const LAS bf16x8*)(lds + PG8_SB(b, h) + boff + n * 2048 + k * 1024); } while (0)
#define PG8_MMA(ai, bj, At, Bt) do { __builtin_amdgcn_s_setprio(1); _Pragma("unroll") for (int m = 0; m < 4; ++m) _Pragma("unroll") for (int n = 0; n < 2; ++n) _Pragma("unroll") for (int k = 0; k < 2; ++k) \
        acc[ai][bj][m][n] = P::SWAP ? __builtin_amdgcn_mfma_f32_16x16x32_bf16(At[m][k], Bt[n][k], acc[ai][bj][m][n], 0, 0, 0) \
                                    : __builtin_amdgcn_mfma_f32_16x16x32_bf16(Bt[n][k], At[m][k], acc[ai][bj][m][n], 0, 0, 0); __builtin_amdgcn_s_setprio(0); } while (0)
#define PG8_WAIT_V(n) asm volatile("s_waitcnt vmcnt(" #n ")" ::: "memory")
#define PG8_WAIT_L(n) asm volatile("s_waitcnt lgkmcnt(" #n ")" ::: "memory")
#define PG8_BAR __builtin_amdgcn_s_barrier()
#define PG8_SCHED __builtin_amdgcn_sched_barrier(0)
#define PG8_STAGE_A(bufoff, base, kb, h, og) do { if constexpr (P::GATHER) { unsigned _v[2] = {og[h][0] + voffA[0], og[h][1] + voffA[1]}; PG8_STAGE(bufoff, gA + (kb), _v); } \
        else { PG8_STAGE(bufoff, gA + (base) + (kb) + (h) * hA, voffA); } } while (0)
#define PG8_STAGE_B(bufoff, base, kb, h) PG8_STAGE(bufoff, gB + (base) + (kb) + (h) * hB, voffB)
#define PG8_GOFFS(u, og) do { if constexpr (P::GATHER) { _Pragma("unroll") for (int _h = 0; _h < 2; ++_h) _Pragma("unroll") for (int _i = 0; _i < 2; ++_i) og[_h][_i] = prob.a_row(u, _h * HALF + Rr[_i]); } } while (0)
    Unit cur, nxt; int ui = 0;
    if (!prob.next(0, cur)) return;
    f32x4 acc[2][2][4][2];
#pragma unroll
    for (int a = 0; a < 2; ++a)
#pragma unroll
        for (int b = 0; b < 2; ++b)
#pragma unroll
            for (int m = 0; m < 4; ++m)
#pragma unroll
                for (int n = 0; n < 2; ++n) acc[a][b][m][n] = (f32x4){0.f, 0.f, 0.f, 0.f};
    bf16x8 At[4][2], B0[2][2], B1[2][2];
    unsigned ogc[2][2] = {{0u, 0u}, {0u, 0u}}, ogn[2][2] = {{0u, 0u}, {0u, 0u}};
    PG8_GOFFS(cur, ogc);
    const char* const gA = prob.A; const char* const gB = prob.B;
    size_t cAb = P::GATHER ? 0 : prob.a_base(cur), cBb = prob.b_base(cur);
    PG8_STAGE_B(PG8_SB(0, 0), cBb, 0, 0); PG8_STAGE_B(PG8_SB(0, 1), cBb, 0, 1); PG8_STAGE_A(PG8_SA(0, 0), cAb, 0, 0, ogc); PG8_STAGE_A(PG8_SA(0, 1), cAb, 0, 1, ogc);
    if (wr == 1) PG8_BAR;
    PG8_WAIT_V(2); PG8_BAR;
    PG8_STAGE_B(PG8_SB(1, 0), cBb, kstep, 0); PG8_STAGE_A(PG8_SA(1, 0), cAb, kstep, 0, ogc); PG8_STAGE_B(PG8_SB(1, 1), cBb, kstep, 1);
    PG8_WAIT_V(6); PG8_BAR;
    for (;;) {
        const bool has_next = prob.next(ui + 1, nxt);
        size_t nAb = cAb, nBb = cBb;
        if (has_next) { nAb = P::GATHER ? 0 : prob.a_base(nxt); nBb = prob.b_base(nxt); }
        for (int t = 0; t < nt; t += 2) {
            const bool last = (t == nt - 2);
            const size_t k1 = (size_t)(t + 1) * kstep;
            const size_t k2 = last ? 0 : (size_t)(t + 2) * kstep, k3 = k2 + kstep;
            const size_t a2 = last ? nAb : cAb, b2 = last ? nBb : cBb;
            if constexpr (P::GATHER) if (last) { if (has_next) { PG8_GOFFS(nxt, ogn); } else {
#pragma unroll
                for (int h = 0; h < 2; ++h)
#pragma unroll
                    for (int i = 0; i < 2; ++i) ogn[h][i] = ogc[h][i]; } }
            unsigned og2[2][2];
#pragma unroll
            for (int h = 0; h < 2; ++h)
#pragma unroll
                for (int i = 0; i < 2; ++i) og2[h][i] = (P::GATHER && last) ? ogn[h][i] : ogc[h][i];
            PG8_LDB(B0, 0, 0); PG8_LDB(B1, 0, 1); PG8_SCHED; PG8_LDA(At, 0, 0); PG8_STAGE_A(PG8_SA(1, 1), cAb, k1, 1, ogc);
            PG8_WAIT_V(8); PG8_WAIT_L(0); PG8_BAR; PG8_MMA(0, 0, At, B0); PG8_MMA(0, 1, At, B1); PG8_BAR; PG8_SCHED;
            PG8_LDA(At, 0, 1); PG8_STAGE_B(PG8_SB(0, 0), b2, k2, 0); PG8_STAGE_B(PG8_SB(0, 1), b2, k2, 1); PG8_STAGE_A(PG8_SA(0, 0), a2, k2, 0, og2);
            PG8_WAIT_V(8); PG8_WAIT_L(0); PG8_BAR; PG8_MMA(1, 0, At, B0); PG8_MMA(1, 1, At, B1); PG8_BAR; PG8_SCHED;
            PG8_LDB(B0, 1, 0); PG8_LDB(B1, 1, 1); PG8_SCHED; PG8_LDA(At, 1, 0); PG8_STAGE_A(PG8_SA(0, 1), a2, k2, 1, og2);
            PG8_WAIT_V(8); PG8_WAIT_L(0); PG8_BAR; PG8_MMA(0, 0, At, B0); PG8_MMA(0, 1, At, B1); PG8_BAR; PG8_SCHED;
            PG8_LDA(At, 1, 1); PG8_STAGE_B(PG8_SB(1, 0), b2, k3, 0); PG8_STAGE_B(PG8_SB(1, 1), b2, k3, 1); PG8_STAGE_A(PG8_SA(1, 0), a2, k3, 0, og2);
            PG8_WAIT_V(8); PG8_WAIT_L(0); PG8_BAR; PG8_MMA(1, 0, At, B0); PG8_MMA(1, 1, At, B1); PG8_BAR; PG8_SCHED;
        }
        if (wr == 0) PG8_BAR;
        prob.epi(acc, cur, wr, wc, fr, fq);
        if (!has_next) break;
#pragma unroll
        for (int a = 0; a < 2; ++a)
#pragma unroll
            for (int b = 0; b < 2; ++b)
#pragma unroll
                for (int m = 0; m < 4; ++m)
#pragma unroll
                    for (int n = 0; n < 2; ++n) acc[a][b][m][n] = (f32x4){0.f, 0.f, 0.f, 0.f};
        cur = nxt; ++ui; cAb = nAb; cBb = nBb;
#pragma unroll
        for (int h = 0; h < 2; ++h)
#pragma unroll
            for (int i = 0; i < 2; ++i) ogc[h][i] = ogn[h][i];
        if (wr == 1) PG8_BAR;
    }
    PG8_WAIT_V(0);
    PG8_BAR;
#undef PG8_SA
#undef PG8_SB
#undef PG8_STAGE
#undef PG8_STAGE_A
#undef PG8_STAGE_B
#undef PG8_GOFFS
#undef PG8_LDA
#undef PG8_LDB
#undef PG8_MMA
#undef PG8_WAIT_V
#undef PG8_WAIT_L
#undef PG8_BAR
#undef PG8_SCHED
}
}
using pg8::Unit;

__device__ __forceinline__ bool static_tile(int i, int G, int c, int nM, int nN, int& pm, int& pn) {
    const int nwg = nM * nN; const long L = (long)i * G + c; if (L >= nwg) return false;
    int wgid = (int)L; { const int q = nwg / 8, r = nwg % 8, xcd = wgid % 8, off = wgid / 8; wgid = (xcd < r ? xcd * (q + 1) : r * (q + 1) + (xcd - r) * q) + off; }
    const int WGM = 8, nig = WGM * nN, gid = wgid / nig, fm = gid * WGM, gsz = (nM - fm) < WGM ? (nM - fm) : WGM;
    pm = fm + ((wgid % nig) % gsz); pn = (wgid % nig) / gsz; return true;
}

struct Args { const float* in[21]; float* out; unsigned char* ws; };
struct Frame {
    LAS unsigned char* lds; unsigned char* ws; const float* const* in; float* out;
    int tid, lane, wave, G, vcu, bx;
};
enum { I_X = 0, I_C, I_WADA, I_BADA, I_WIN, I_BF, I_FOXG, I_SBG, I_WOUT, I_LN1G, I_LN1B, I_WR, I_RB, I_WGE, I_WUE, I_WDE, I_WGS, I_WUS, I_WDS, I_LN2G, I_LN2B };

__device__ __forceinline__ void transpose_item(const float* W, int ldw, int k0, int nsrc0, bf16_t* WT, bf16_t* WT_lo, int Kd, int drow0, LAS float* scr, int lane) {
#pragma unroll 8
    for (int i = 0; i < 32; ++i) { const int kk = 2 * i + (lane >> 5); scr[kk * 33 + (lane & 31)] = W[(size_t)(k0 + kk) * ldw + nsrc0 + (lane & 31)]; }
    LDS_WAIT(); asm volatile("" ::: "memory");
    const int c = lane & 7;
#pragma unroll
    for (int j = 0; j < 4; ++j) { const int n = (lane >> 3) + 8 * j; const LAS float* s = scr + (8 * c) * 33 + n;
        float v[8];
#pragma unroll
        for (int q = 0; q < 8; ++q) v[q] = s[q * 33];
        u32x4 o; o.x = pk2(v[0], v[1]); o.y = pk2(v[2], v[3]); o.z = pk2(v[4], v[5]); o.w = pk2(v[6], v[7]);
        *(GAS u32x4*)(WT + (size_t)(drow0 + n) * Kd + k0 + 8 * c) = o;
        if (WT_lo) {
            float r[8];
#pragma unroll
            for (int q = 0; q < 8; ++q) r[q] = v[q] - bf2f(f2bf(v[q]));
            u32x4 p; p.x = pk2(r[0], r[1]); p.y = pk2(r[2], r[3]); p.z = pk2(r[4], r[5]); p.w = pk2(r[6], r[7]);
            *(GAS u32x4*)(WT_lo + (size_t)(drow0 + n) * Kd + k0 + 8 * c) = p;
        } }
    LDS_WAIT(); asm volatile("" ::: "memory");
}

__device__ __forceinline__ void phase0(Frame& F) {
    const int gw = F.vcu * NWAVES + F.wave, NGW = F.G * NWAVES;
    unsigned char* ws = F.ws;
    LAS float* sc = (LAS float*)(F.lds);
    for (int i = F.tid; i < NB * DM; i += NTHR) { const float v = F.in[I_C][i]; sc[i] = v / (1.f + __expf(-v)); }
    __syncthreads();
    if (gw < 192) {
        const int nc = gw % 24, kq = gw / 24; const float* W = F.in[I_WADA];
        f32x4 a[4];
#pragma unroll
        for (int b = 0; b < 4; ++b) a[b] = (f32x4){0.f, 0.f, 0.f, 0.f};
        const int col = nc * 256 + F.lane * 4;
#pragma unroll 16
        for (int k = kq * 128; k < kq * 128 + 128; ++k) {
            const f32x4 w = *(const GAS f32x4*)(W + (size_t)k * 6144 + col);
#pragma unroll
            for (int b = 0; b < 4; ++b) a[b] += w * sc[b * DM + k];
        }
        float* part = (float*)(ws + WS_ADAP);
#pragma unroll
        for (int b = 0; b < 4; ++b) *(GAS f32x4*)(part + ((size_t)kq * 4 + b) * 6144 + col) = a[b];
    }
    { float* wf = (float*)(ws + WS_WF); const float* W = F.in[I_WIN];
      for (int i = F.bx * NTHR + F.tid; i < 8 * DM; i += F.G * NTHR) { const int hh = i >> 10, k = i & 1023; wf[i] = W[(size_t)k * DIN + NQKV + hh]; } }
    LAS float* scr = (LAS float*)(F.lds + 16384 + F.wave * 12288);
    bf16_t* win = (bf16_t*)(ws + WS_WIN); bf16_t* wout = (bf16_t*)(ws + WS_WOUT); bf16_t* wr = (bf16_t*)(ws + WS_WR);
    bf16_t* wsgu = (bf16_t*)(ws + WS_WSGU); bf16_t* wsd = (bf16_t*)(ws + WS_WSD); bf16_t* wgu = (bf16_t*)(ws + WS_WGU); bf16_t* wd = (bf16_t*)(ws + WS_WD);
    constexpr int I_IN = 16 * 96, I_OUT = 16 * 32, I_R = 16 * 8, I_SGU = 16 * 16, I_SD = 4 * 32, I_SMALL = I_IN + I_OUT + I_R + I_SGU + I_SD;
    constexpr int I_EGU = 16 * 16, I_ED = 4 * 32, I_E = I_EGU + I_ED;
    const int NITEMS = I_SMALL;
    for (int it = gw; it < NITEMS; it += NGW) {
        int r = it;
        if (r < I_IN) { const int kb = r / 96, nb = r % 96; transpose_item(F.in[I_WIN], DIN, 64 * kb, 32 * nb, win, nullptr, DM, 32 * nb, scr, F.lane); continue; } r -= I_IN;
        if (r < I_OUT) { const int kb = r / 32, nb = r % 32; transpose_item(F.in[I_WOUT], DM, 64 * kb, 32 * nb, wout, nullptr, DM, 32 * nb, scr, F.lane); continue; } r -= I_OUT;
        if (r < I_R) { const int kb = r / 8, nb = r % 8; transpose_item(F.in[I_WR], NEXP, 64 * kb, 32 * nb, wr, wr + NEXP * DM, DM, 32 * nb, scr, F.lane); continue; } r -= I_R;
        if (r < I_SGU) { const int kb = r / 16, nb = r % 16, ct = nb >> 3, half = (nb >> 2) & 1, jb = nb & 3;
            transpose_item(half ? F.in[I_WUS] : F.in[I_WGS], DEXP, 64 * kb, 128 * ct + 32 * jb, wsgu, nullptr, DM, 32 * nb, scr, F.lane); continue; } r -= I_SGU;
        if (r < I_SD) { const int kb = r / 32, nb = r % 32; transpose_item(F.in[I_WDS], DM, 64 * kb, 32 * nb, wsd, nullptr, DEXP, 32 * nb, scr, F.lane); continue; } r -= I_SD;
        const int e = r / I_E; r -= e * I_E;
        if (r < I_EGU) { const int kb = r / 16, nb = r % 16, ct = nb >> 3, half = (nb >> 2) & 1, jb = nb & 3;
            const float* src = (half ? F.in[I_WUE] : F.in[I_WGE]) + (size_t)e * DM * DEXP;
            transpose_item(src, DEXP, 64 * kb, 128 * ct + 32 * jb, wgu + (size_t)e * 512 * DM, nullptr, DM, 32 * nb, scr, F.lane); continue; } r -= I_EGU;
        { const int kb = r / 32, nb = r % 32; transpose_item(F.in[I_WDE] + (size_t)e * DEXP * DM, DM, 64 * kb, 32 * nb, wd + (size_t)e * DM * DEXP, nullptr, DEXP, 32 * nb, scr, F.lane); }
    }
}

__device__ __forceinline__ float ada_from_partials(const float* part, const float* bada, int b, int j) {
    float a = 0.f;
#pragma unroll
    for (int q = 0; q < 8; ++q) a += part[(q * 4 + b) * 6144 + j];
    return bada[j] + a;
}
__device__ __forceinline__ void phase1(Frame& F) {
    unsigned char* ws = F.ws; const float* part = (const float*)(ws + WS_ADAP); const float* bada = F.in[I_BADA];
    LAS float* tab = (LAS float*)F.lds;
    LAS float* wfl = (LAS float*)(F.lds + 32768);
    for (int i = F.tid; i < NB * 2 * DM; i += NTHR) { const int b = i >> 11, which = (i >> 10) & 1, d = i & 1023;
        const float v = ada_from_partials(part, bada, b, (which == 0 ? 1024 : 0) + d); tab[i] = which == 0 ? 1.f + v : v; }
    { const float* wf = (const float*)(ws + WS_WF); for (int i = F.tid; i < 8 * DM; i += NTHR) wfl[i] = wf[i]; }
    { float* ada = (float*)(ws + WS_ADA);
      for (int j = F.bx * NTHR + F.tid; j < NB * 6144; j += F.G * NTHR) ada[j] = ada_from_partials(part, bada, j / 6144, j % 6144); }
    __syncthreads();
    const int gw = F.vcu * NWAVES + F.wave, NGW = F.G * NWAVES;
    const float* x = F.in[I_X]; bf16_t* u1 = (bf16_t*)(ws + WS_U1); float* logf = (float*)(ws + WS_LOGF);
    const float bfv = F.in[I_BF][F.lane & 7];
    for (int m0 = gw; m0 < NTOK; m0 += 2 * NGW) {
        f32x4 xv[2][4];
#pragma unroll
        for (int rr = 0; rr < 2; ++rr) { const int m = m0 + rr * NGW;
#pragma unroll
            for (int j = 0; j < 4; ++j) xv[rr][j] = (m < NTOK) ? *(const GAS f32x4*)(x + (size_t)m * DM + 4 * F.lane + 256 * j) : (f32x4){0.f, 0.f, 0.f, 0.f}; }
#pragma unroll
        for (int rr = 0; rr < 2; ++rr) { const int m = m0 + rr * NGW; if (m >= NTOK) break;
            const int b = m >> 12, s = m & 4095;
            f32x4 u[4];
#pragma unroll
            for (int j = 0; j < 4; ++j) { const int d = 4 * F.lane + 256 * j;
                const f32x4 sc = *(const LAS f32x4*)(tab + (b * 2 + 0) * DM + d), sh = *(const LAS f32x4*)(tab + (b * 2 + 1) * DM + d);
                u[j] = xv[rr][j] * sc + sh;
                u32x2 w; w.x = pk2(u[j][0], u[j][1]); w.y = pk2(u[j][2], u[j][3]); *(GAS u32x2*)(u1 + (size_t)m * DM + d) = w; }
            float fl[8];
#pragma unroll
            for (int hh = 0; hh < 8; ++hh) { float a = 0.f;
#pragma unroll
                for (int j = 0; j < 4; ++j) { const f32x4 w = *(const LAS f32x4*)(wfl + hh * DM + 4 * F.lane + 256 * j); a += (u[j][0] * w[0] + u[j][1] * w[1]) + (u[j][2] * w[2] + u[j][3] * w[3]); }
                fl[hh] = a; }
#pragma unroll
            for (int o = 1; o < 64; o <<= 1) {
#pragma unroll
                for (int hh = 0; hh < 8; ++hh) fl[hh] += __shfl_xor(fl[hh], o); }
            if (F.lane < 8) { float v = 0.f;
#pragma unroll
                for (int hh = 0; hh < 8; ++hh) v = (F.lane == hh) ? fl[hh] : v;
                v += bfv;
                const float ls = fminf(v, 0.f) - log1pf(expf(-fabsf(v)));
                logf[((size_t)(b * 8 + F.lane)) * SEQ + s] = ls * LOG2E; }
        }
    }
}

__device__ __forceinline__ void fcum_block(Frame& F, int seq) {
    const float* logf = (const float*)(F.ws + WS_LOGF) + (size_t)seq * SEQ; float* fc = (float*)(F.ws + WS_FCUM) + (size_t)seq * SEQ;
    LAS float* part = (LAS float*)F.lds;
    float v[8]; float run = 0.f;
#pragma unroll
    for (int i = 0; i < 8; ++i) { run += logf[F.tid * 8 + i]; v[i] = run; }
    part[F.tid] = run; __syncthreads();
    if (F.tid == 0) { float a = 0.f; for (int i = 0; i < NTHR; ++i) { const float t = part[i]; part[i] = a; a += t; } }
    __syncthreads();
    const float base = part[F.tid];
#pragma unroll
    for (int i = 0; i < 8; ++i) fc[F.tid * 8 + i] = base + v[i];
    __syncthreads();
}

struct ProbQK {
    static constexpr bool PERM = true, SWAP = false, GATHER = false;
    const char* A; const char* B; int K, lda, ldb; int G, c; bf16_t* qk;
    __device__ __forceinline__ bool next(int i, Unit& u) const { int pm, pn; if (!static_tile(i, G, c, 64, 8, pm, pn)) return false; u.pm = pm; u.pn = pn < 4 ? pn : pn + 2; u.e = -1; u.cnt = 0; return true; }
    __device__ __forceinline__ size_t a_base(const Unit& u) const { return (size_t)(u.pm * 256) * 2048u; }
    __device__ __forceinline__ size_t b_base(const Unit& u) const { return (size_t)(u.pn * 256) * 2048u; }
    __device__ __forceinline__ void epi(const f32x4 (&acc)[2][2][4][2], const Unit& u, int wr, int wc, int fr, int fq) const {
        const float sc = (u.pn == 0 || u.pn == 1 || u.pn == 6 || u.pn == 7) ? QSCALE : 1.f;
#pragma unroll
        for (int ai = 0; ai < 2; ++ai)
#pragma unroll
            for (int m = 0; m < 4; ++m) { bf16_t* rowp = qk + (size_t)(u.pm * 256 + ai * 128 + wr * 64 + m * 16 + fr) * NQKV + u.pn * 256 + wc * 32 + 8 * fq;
#pragma unroll
                for (int bj = 0; bj < 2; ++bj) { const f32x4 v0 = acc[ai][bj][m][0] * sc, v1 = acc[ai][bj][m][1] * sc; u32x4 w;
                    w.x = cvt_pk_bf16(v0[0], v0[1]); w.y = cvt_pk_bf16(v0[2], v0[3]); w.z = cvt_pk_bf16(v1[0], v1[1]); w.w = cvt_pk_bf16(v1[2], v1[3]);
                    *(GAS u32x4*)(rowp + bj * 128) = w; } }
    }
};
struct ProbVT {
    static constexpr bool PERM = false, SWAP = true, GATHER = false;
    const char* A; const char* B; int K, lda, ldb; int G, c; bf16_t* vt;
    __device__ __forceinline__ bool next(int i, Unit& u) const { int pm, pn; if (!static_tile(i, G, c, 64, 4, pm, pn)) return false; u.pm = pm; u.pn = pn < 2 ? 4 + pn : 8 + pn; u.e = -1; u.cnt = 0; return true; }
    __device__ __forceinline__ size_t a_base(const Unit& u) const { return (size_t)(u.pm * 256) * 2048u; }
    __device__ __forceinline__ size_t b_base(const Unit& u) const { return (size_t)(u.pn * 256) * 2048u; }
    __device__ __forceinline__ void epi(const f32x4 (&acc)[2][2][4][2], const Unit& u, int wr, int wc, int fr, int fq) const {
        const int hg0 = (u.pn < 6) ? (u.pn - 4) * 4 : 8 + (u.pn - 10) * 4;
#pragma unroll
        for (int bj = 0; bj < 2; ++bj)
#pragma unroll
            for (int n = 0; n < 2; ++n) { const int cl = bj * 128 + wc * 32 + n * 16 + fr, hg = hg0 + (cl >> 6), d = cl & 63;
#pragma unroll
                for (int ai = 0; ai < 2; ++ai)
#pragma unroll
                    for (int m = 0; m < 4; ++m) { const int row = u.pm * 256 + ai * 128 + wr * 64 + m * 16 + 4 * fq, b = row >> 12, s = row & 4095;
                        const f32x4 v = acc[ai][bj][m][n]; u32x2 w; w.x = cvt_pk_bf16(v[0], v[1]); w.y = cvt_pk_bf16(v[2], v[3]);
                        *(GAS u32x2*)(vt + ((size_t)((b * 16 + hg) * 64 + d)) * SEQ + s) = w; } }
    }
};
struct ProbZ {
    static constexpr bool PERM = false, SWAP = false, GATHER = false;
    const char* A; const char* B; int K, lda, ldb; int G, c; const float* x; const float* ada; float* z;
    __device__ __forceinline__ bool next(int i, Unit& u) const { int pm, pn; if (!static_tile(i, G, c, 64, 4, pm, pn)) return false; u.pm = pm; u.pn = pn; u.e = -1; u.cnt = 0; return true; }
    __device__ __forceinline__ size_t a_base(const Unit& u) const { return (size_t)(u.pm * 256) * 2048u; }
    __device__ __forceinline__ size_t b_base(const Unit& u) const { return (size_t)(u.pn * 256) * 2048u; }
    __device__ __forceinline__ void epi(const f32x4 (&acc)[2][2][4][2], const Unit& u, int wr, int wc, int fr, int fq) const {
        const int b = (u.pm * 256) >> 12; const int col0 = u.pn * 256 + wc * 32 + 4 * fq;
#pragma unroll
        for (int bj = 0; bj < 2; ++bj)
#pragma unroll
            for (int n = 0; n < 2; ++n) { const int col = col0 + bj * 128 + n * 16; const f32x4 gv = *(const GAS f32x4*)(ada + b * 6144 + 2048 + col) + 1.0f;
#pragma unroll
                for (int ai = 0; ai < 2; ++ai)
#pragma unroll
                    for (int m = 0; m < 4; ++m) { const size_t off = (size_t)(u.pm * 256 + ai * 128 + wr * 64 + m * 16 + fr) * DM + col;
                        const f32x4 xv = *(const GAS f32x4*)(x + off); *(GAS f32x4*)(z + off) = xv * ALPHA + gv * acc[ai][bj][m][n]; } }
    }
};
struct ProbP6 {
    static constexpr bool PERM = true, SWAP = false, GATHER = false;
    const char* A; const char* B; int K, lda, ldb; int G, c; float* logits; bf16_t* hs;
    __device__ __forceinline__ bool next(int i, Unit& u) const { const int L = i * G + c; if (L >= 192 + 128) return false;
        if (L < 192) { u.pm = L / 3; u.e = L % 3; u.pn = 0; } else { u.pm = (L - 192) >> 1; u.pn = (L - 192) & 1; u.e = -1; } u.cnt = 0; return true; }
    __device__ __forceinline__ size_t a_base(const Unit& u) const { return (size_t)(u.pm * 256) * 4096u + (u.e == 1 ? 2048u : 0u); }
    __device__ __forceinline__ size_t b_base(const Unit& u) const {
        if (u.e >= 0) return (size_t)(u.e == 2 ? 256 : 0) * 2048u;
        return (size_t)(WS_WSGU - WS_WR) + (size_t)(u.pn * 256) * 2048u; }
    __device__ __forceinline__ void epi(const f32x4 (&acc)[2][2][4][2], const Unit& u, int wr, int wc, int fr, int fq) const {
        if (u.e >= 0) {
            float* out = logits + (size_t)u.e * NTOK * NEXP;
#pragma unroll
            for (int ai = 0; ai < 2; ++ai)
#pragma unroll
                for (int m = 0; m < 4; ++m) { float* rowp = out + (size_t)(u.pm * 256 + ai * 128 + wr * 64 + m * 16 + fr) * NEXP + wc * 32 + 8 * fq;
#pragma unroll
                    for (int bj = 0; bj < 2; ++bj) { *(GAS f32x4*)(rowp + bj * 128) = acc[ai][bj][m][0]; *(GAS f32x4*)(rowp + bj * 128 + 4) = acc[ai][bj][m][1]; } }
        } else {
#pragma unroll
            for (int ai = 0; ai < 2; ++ai)
#pragma unroll
                for (int m = 0; m < 4; ++m) { bf16_t* rowp = hs + (size_t)(u.pm * 256 + ai * 128 + wr * 64 + m * 16 + fr) * DEXP + u.pn * 128 + wc * 32 + 8 * fq;
                    float h[8];
#pragma unroll
                    for (int n = 0; n < 2; ++n)
#pragma unroll
                        for (int q = 0; q < 4; ++q) { const float g = acc[ai][0][m][n][q], up = acc[ai][1][m][n][q]; h[n * 4 + q] = g / (1.f + __expf(-g)) * up; }
                    u32x4 w; w.x = cvt_pk_bf16(h[0], h[1]); w.y = cvt_pk_bf16(h[2], h[3]); w.z = cvt_pk_bf16(h[4], h[5]); w.w = cvt_pk_bf16(h[6], h[7]);
                    *(GAS u32x4*)rowp = w; }
        }
    }
};
struct ExpTab { const LAS int* ts; int NT; const unsigned* cnt; const int* list; };
__device__ __forceinline__ int exp_of_tile(const ExpTab& T, int tile) { int lo = 0, hi = NEXP;
    while (hi - lo > 1) { const int mid = (lo + hi) >> 1; if (T.ts[mid] <= tile) lo = mid; else hi = mid; } return lo; }
struct ProbP8 {
    static constexpr bool PERM = true, SWAP = false, GATHER = true;
    const char* A; const char* B; int K, lda, ldb; int G, c; ExpTab T; bf16_t* h;
    __device__ __forceinline__ bool next(int i, Unit& u) const { const int L = i * G + c; if (L >= T.NT * 2) return false; const int tile = L >> 1; u.pn = L & 1;
        const int e = exp_of_tile(T, tile); u.e = e; u.pm = tile; u.cnt = (int)T.cnt[e] - 256 * (tile - T.ts[e]); return true; }
    __device__ __forceinline__ size_t a_base(const Unit&) const { return 0; }
    __device__ __forceinline__ unsigned a_row(const Unit& u, int r) const { const int pos = r < u.cnt ? 256 * (u.pm - T.ts[u.e]) + r : 0; const int a = T.list[(size_t)u.e * LIST_CAP + pos]; return (unsigned)(a >> 3) * 4096u; }
    __device__ __forceinline__ size_t b_base(const Unit& u) const { return (size_t)(u.e * 512 + u.pn * 256) * 2048u; }
    __device__ __forceinline__ void epi(const f32x4 (&acc)[2][2][4][2], const Unit& u, int wr, int wc, int fr, int fq) const {
#pragma unroll
        for (int ai = 0; ai < 2; ++ai)
#pragma unroll
            for (int m = 0; m < 4; ++m) { bf16_t* rowp = h + (size_t)(u.pm * 256 + ai * 128 + wr * 64 + m * 16 + fr) * DEXP + u.pn * 128 + wc * 32 + 8 * fq;
                float hv[8];
#pragma unroll
                for (int n = 0; n < 2; ++n)
#pragma unroll
                    for (int q = 0; q < 4; ++q) { const float g = acc[ai][0][m][n][q], up = acc[ai][1][m][n][q]; hv[n * 4 + q] = g / (1.f + __expf(-g)) * up; }
                u32x4 w; w.x = cvt_pk_bf16(hv[0], hv[1]); w.y = cvt_pk_bf16(hv[2], hv[3]); w.z = cvt_pk_bf16(hv[4], hv[5]); w.w = cvt_pk_bf16(hv[6], hv[7]);
                *(GAS u32x4*)rowp = w; }
    }
};
struct ProbP9 {
    static constexpr bool PERM = true, SWAP = false, GATHER = false;
    const char* A; const char* B; int K, lda, ldb; int G, c; ExpTab T; const float* topw; bf16_t* y; bf16_t* ys;
    __device__ __forceinline__ bool next(int i, Unit& u) const { const int L = i * G + c; const int NR = T.NT * 4; if (L >= NR + 256) return false;
        if (L < NR) { const int tile = L >> 2; u.pn = L & 3; const int e = exp_of_tile(T, tile); u.e = e; u.pm = tile; u.cnt = (int)T.cnt[e] - 256 * (tile - T.ts[e]); }
        else { const int q = L - NR; u.pm = q >> 2; u.pn = q & 3; u.e = -1; u.cnt = 256; } return true; }
    __device__ __forceinline__ size_t a_base(const Unit& u) const { return (u.e >= 0 ? (size_t)(WS_H - WS_HS) : (size_t)0) + (size_t)(u.pm * 256) * 512u; }
    __device__ __forceinline__ size_t b_base(const Unit& u) const { return u.e >= 0 ? (size_t)(WS_WD - WS_WSD) + (size_t)(u.e * 1024 + u.pn * 256) * 512u : (size_t)(u.pn * 256) * 512u; }
    __device__ __forceinline__ void epi(const f32x4 (&acc)[2][2][4][2], const Unit& u, int wr, int wc, int fr, int fq) const {
        bf16_t* base = (bf16_t*)((unsigned char*)ys + (u.e >= 0 ? (size_t)(WS_Y - WS_YS) : (size_t)0)) + (size_t)(u.pm * 256) * DM + u.pn * 256 + wc * 32 + 8 * fq;
#pragma unroll
        for (int ai = 0; ai < 2; ++ai)
#pragma unroll
            for (int m = 0; m < 4; ++m) { const int r = ai * 128 + wr * 64 + m * 16 + fr;
                if (r < u.cnt) { bf16_t* rowp = base + (size_t)r * DM;
#pragma unroll
                    for (int bj = 0; bj < 2; ++bj) { const f32x4 v0 = acc[ai][bj][m][0], v1 = acc[ai][bj][m][1]; u32x4 o;
                        o.x = cvt_pk_bf16(v0[0], v0[1]); o.y = cvt_pk_bf16(v0[2], v0[3]); o.z = cvt_pk_bf16(v1[0], v1[1]); o.w = cvt_pk_bf16(v1[2], v1[3]);
                        *(GAS u32x4*)(rowp + bj * 128) = o; } } }
    }
};

struct Cvt { const float* wge; const float* wue; const float* wde; bf16_t* wgu; bf16_t* wd; int e, r, pend, pend_e; f32x4 v[8]; };
__device__ __forceinline__ void cvt_retire(Cvt& c, int lane) {
    const int r = c.pend, e = c.pend_e, kg = lane >> 3, n4 = lane & 7;
    bf16_t* dst; size_t rstride;
    if (r < 256) { const int mat = r >> 7, q = r & 127, kb = q >> 3, nb = q & 7, n = 32 * nb + 4 * n4, ct = n >> 7, j = n & 127;
        dst = c.wgu + ((size_t)e * 512 + 256 * ct + 128 * mat + j) * DM + 64 * kb + 8 * kg; rstride = DM; }
    else { const int q = r - 256, kb = q >> 5, nb = q & 31;
        dst = c.wd + ((size_t)e * DM + 32 * nb + 4 * n4) * DEXP + 64 * kb + 8 * kg; rstride = DEXP; }
#pragma unroll
    for (int i = 0; i < 4; ++i) { u32x4 o; o.x = cvt_pk_bf16(c.v[0][i], c.v[1][i]); o.y = cvt_pk_bf16(c.v[2][i], c.v[3][i]); o.z = cvt_pk_bf16(c.v[4][i], c.v[5][i]); o.w = cvt_pk_bf16(c.v[6][i], c.v[7][i]);
        *(GAS u32x4*)(dst + (size_t)i * rstride) = o; }
}
__device__ __forceinline__ void cvt_issue(Cvt& c, int lane) {
    const int r = c.r, kg = lane >> 3, n4 = lane & 7; const float* src; size_t sstride;
    if (r < 256) { const int mat = r >> 7, q = r & 127, kb = q >> 3, nb = q & 7; src = (mat ? c.wue : c.wge) + (size_t)c.e * DM * DEXP + (size_t)(64 * kb + 8 * kg) * DEXP + 32 * nb + 4 * n4; sstride = DEXP; }
    else { const int q = r - 256, kb = q >> 5, nb = q & 31; src = c.wde + (size_t)c.e * DEXP * DM + (size_t)(64 * kb + 8 * kg) * DM + 32 * nb + 4 * n4; sstride = DM; }
#pragma unroll
    for (int kk = 0; kk < 8; ++kk) c.v[kk] = *(const GAS f32x4*)(src + kk * sstride);
}
__device__ __forceinline__ void cvt_tick(Cvt& c, int lane, int G) {
    if (c.pend >= 0) { cvt_retire(c, lane); c.pend = -1; }
    if (c.e < NEXP) { cvt_issue(c, lane); c.pend = c.r; c.pend_e = c.e; c.r += NWAVES; if (c.r >= 384) { c.r -= 384; c.e += G; } }
}

constexpr int AT_TILE = 8192;
constexpr int AT_K = 0, AT_V = 2 * AT_TILE, AT_F = 4 * AT_TILE, AT_BUF = 4 * AT_TILE + 512;
__device__ __forceinline__ int at_sw(int row, int chunk) { return row * 128 + ((chunk ^ (row & 7)) << 4); }

template <int TYPE>
__device__ __forceinline__ void attn_unit(Frame& F, Cvt& cv, int b, int hh, int qb) {
    LAS unsigned char* lds = F.lds;
    const int tid = F.tid, lane = F.lane, w = F.wave, r = lane & 31, hf = lane >> 5;
    const bf16_t* qk = (const bf16_t*)(F.ws + WS_QK); const bf16_t* vt = (const bf16_t*)(F.ws + WS_VT); bf16_t* o = (bf16_t*)(F.ws + WS_O);
    const float* fcum = (const float*)(F.ws + WS_FCUM) + (size_t)(b * 8 + hh) * SEQ;
    const int qcol = (TYPE == 0 ? 0 : 1536) + hh * 64, kcol = (TYPE == 0 ? 512 : 2048) + hh * 64, hg = TYPE * 8 + hh;
    const int q0 = qb * 256, qrow = q0 + 32 * w + r;
    const size_t tok0 = (size_t)b * SEQ;
    bf16x8 qf[4];
#pragma unroll
    for (int s = 0; s < 4; ++s) qf[s] = *(const GAS bf16x8*)(qk + (tok0 + qrow) * NQKV + qcol + 16 * s + 8 * hf);
    const float fq2 = TYPE == 0 ? fcum[qrow] : 0.f;
    const int srow = tid >> 3, sch = tid & 7;
    const bf16_t* kg = qk + (tok0 + srow) * NQKV + kcol + 8 * sch;
    const bf16_t* vg = vt + ((size_t)((b * 16 + hg) * 64 + srow)) * SEQ + 8 * sch;
    const int sdst = at_sw(srow, sch);
    const int ntiles = 4 * (qb + 1), jw = 4 * qb + (w >> 1);
    const int pir = (r & 0x13) | ((r & 4) << 1) | ((r & 8) >> 1);
    bf16x8 tneg[2];
    if (TYPE == 1) {
#pragma unroll
        for (int s2 = 0; s2 < 2; ++s2)
#pragma unroll
            for (int j = 0; j < 8; ++j) tneg[s2][j] = (16 * s2 + 8 * hf + j > pir) ? (short)0xBF80 : (short)0;
    }
    f32x16 oacc[2];
#pragma unroll
    for (int i = 0; i < 16; ++i) { oacc[0][i] = 0.f; oacc[1][i] = 0.f; }
    float mrun = -1e30f, lrun = 0.f, Rrun = 0.f;

    const int jfirst = TYPE == 0 ? 0 : ntiles - 1, jstep = TYPE == 0 ? 1 : -1;
    { const int j = jfirst; const u32x4 kv = *(const GAS u32x4*)(kg + (size_t)64 * j * NQKV), vv = *(const GAS u32x4*)(vg + 64 * j);
      *(LAS u32x4*)(lds + AT_K + sdst) = kv; *(LAS u32x4*)(lds + AT_V + sdst) = vv;
      if (TYPE == 0 && tid < 64) *(LAS float*)(lds + AT_F + tid * 4) = fcum[64 * j + tid]; }
    __syncthreads();
    for (int it = 0; it < ntiles; ++it) {
        const int j = jfirst + it * jstep, cur = it & 1, nb = cur ^ 1;
        const bool more = it + 1 < ntiles;
        u32x4 kvn, vvn; float fn = 0.f;
#if !defined(CVT_TAIL_ONLY)
        cvt_tick(cv, lane, F.G);
#endif
        if (more) { const int jn = j + jstep; kvn = *(const GAS u32x4*)(kg + (size_t)64 * jn * NQKV); vvn = *(const GAS u32x4*)(vg + 64 * jn); if (TYPE == 0 && tid < 64) fn = fcum[64 * jn + tid]; }
        if (j <= jw) {
            LAS unsigned char* kt = lds + AT_K + cur * AT_TILE; LAS unsigned char* vtl = lds + AT_V + cur * AT_TILE; const LAS float* ft = (const LAS float*)(lds + AT_F + cur * 256);
            const bool diag = (j == jw);
#pragma unroll
            for (int kb0 = 0; kb0 < 2; ++kb0) {
                const int kb = TYPE == 0 ? kb0 : 1 - kb0;
                const bool skip = diag && ((w & 1) == 0) && kb == 1;
                if (!skip) {
                    const bool mask = diag && (((w & 1) == 0) ? (kb == 0) : (kb == 1));
                    f32x16 s;
#pragma unroll
                    for (int i = 0; i < 16; ++i) s[i] = 0.f;
#pragma unroll
                    for (int st = 0; st < 4; ++st) { const bf16x8 kf = *(const LAS bf16x8*)(kt + at_sw(32 * kb + pir, 2 * st + hf)); s = __builtin_amdgcn_mfma_f32_32x32x16_bf16(kf, qf[st], s, 0, 0, 0); }
                    bf16x8 pf[2];
                    if (TYPE == 0) {
                        f32x4 fk[4];
#pragma unroll
                        for (int g = 0; g < 2; ++g) { fk[2 * g] = *(const LAS f32x4*)(ft + 32 * kb + 16 * g + 8 * hf); fk[2 * g + 1] = *(const LAS f32x4*)(ft + 32 * kb + 16 * g + 8 * hf + 4); }
                        float mx = -1e30f;
#pragma unroll
                        for (int i = 0; i < 16; ++i) { float v = s[i] + (fq2 - fk[i >> 2][i & 3]); if (mask && (16 * (i >> 3) + 8 * hf + (i & 7) > r)) v = -1e30f; s[i] = v; mx = fmaxf(mx, v); }
                        mx = fmaxf(mx, __shfl_xor(mx, 32));
                        if (__any(mx > mrun + 4.0f)) { const float mn = fmaxf(mrun, mx), al = __builtin_amdgcn_exp2f(mrun - mn); mrun = mn; lrun *= al;
#pragma unroll
                            for (int i = 0; i < 16; ++i) { oacc[0][i] *= al; oacc[1][i] *= al; } }
                        float ps = 0.f;
#pragma unroll
                        for (int i = 0; i < 16; ++i) { const float p = __builtin_amdgcn_exp2f(s[i] - mrun); s[i] = p; ps += p; }
                        lrun += ps;
                    } else {
                        float ls = 0.f; f32x16 cin; unsigned lp[8];
#pragma unroll
                        for (int i = 0; i < 16; ++i) { const float z = s[i]; float L = z > 30.f ? z : __builtin_amdgcn_logf(1.f + __builtin_amdgcn_exp2f(z));
                            const bool valid = !(mask && (16 * (i >> 3) + 8 * hf + (i & 7) >= r));
                            L = valid ? L : 0.f; ls += L; cin[i] = z - L - Rrun; s[i] = L; }
#pragma unroll
                        for (int i = 0; i < 8; ++i) lp[i] = cvt_pk_bf16(s[2 * i], s[2 * i + 1]);
                        bf16x8 lf0, lf1; { u32x4 t0 = {lp[0], lp[1], lp[2], lp[3]}, t1 = {lp[4], lp[5], lp[6], lp[7]}; lf0 = __builtin_bit_cast(bf16x8, t0); lf1 = __builtin_bit_cast(bf16x8, t1); }
#if defined(DBG_VALU_CUM)
                        {
                          float G0 = 0.f, G1 = 0.f;
#pragma unroll
                          for (int i = 0; i < 8; ++i) { G0 += s[i]; G1 += s[8 + i]; }
                          const float PG0 = __shfl_xor(G0, 32), PG1 = __shfl_xor(G1, 32);
                          const float later0 = (hf == 0 ? PG0 : 0.f) + G1 + PG1;
                          const float later1 = (hf == 0 ? PG1 : 0.f);
                          float run = 0.f;
#pragma unroll
                          for (int i = 7; i >= 0; --i) { cin[i] -= run + later0; run += s[i]; }
                          run = 0.f;
#pragma unroll
                          for (int i = 15; i >= 8; --i) { cin[i] -= run + later1; run += s[i]; } }
                        asm volatile("" :: "v"(lf0), "v"(lf1));
#else
                        cin = __builtin_amdgcn_mfma_f32_32x32x16_bf16(tneg[0], lf0, cin, 0, 0, 0);
                        cin = __builtin_amdgcn_mfma_f32_32x32x16_bf16(tneg[1], lf1, cin, 0, 0, 0);
#endif
#pragma unroll
                        for (int i = 0; i < 16; ++i) { const bool valid = !(mask && (16 * (i >> 3) + 8 * hf + (i & 7) >= r)); s[i] = valid ? __builtin_amdgcn_exp2f(cin[i]) : 0.f; }
                        ls += __shfl_xor(ls, 32); Rrun += ls;
                    }
                    { unsigned pp[8];
#pragma unroll
                      for (int i = 0; i < 8; ++i) pp[i] = cvt_pk_bf16(s[2 * i], s[2 * i + 1]);
                      u32x4 t0 = {pp[0], pp[1], pp[2], pp[3]}, t1 = {pp[4], pp[5], pp[6], pp[7]}; pf[0] = __builtin_bit_cast(bf16x8, t0); pf[1] = __builtin_bit_cast(bf16x8, t1); }
#pragma unroll
                    for (int dt = 0; dt < 2; ++dt)
#pragma unroll
                        for (int s2 = 0; s2 < 2; ++s2) { const bf16x8 vf = *(const LAS bf16x8*)(vtl + at_sw(32 * dt + r, 4 * kb + 2 * s2 + hf)); oacc[dt] = __builtin_amdgcn_mfma_f32_32x32x16_bf16(vf, pf[s2], oacc[dt], 0, 0, 0); }
                }
            }
        }
        if (more) { *(LAS u32x4*)(lds + AT_K + nb * AT_TILE + sdst) = kvn; *(LAS u32x4*)(lds + AT_V + nb * AT_TILE + sdst) = vvn; if (TYPE == 0 && tid < 64) *(LAS float*)(lds + AT_F + nb * 256 + tid * 4) = fn; }
        if (TYPE == 1) { const bool done = __all(Rrun > 160.f); if (lane == 0) *(LAS unsigned*)(lds + AT_F + (it & 1) * 32 + w * 4) = done ? 1u : 0u; }
        __syncthreads();
        if (TYPE == 1) { const u32x4 d0 = *(const LAS u32x4*)(lds + AT_F + (it & 1) * 32), d1 = *(const LAS u32x4*)(lds + AT_F + (it & 1) * 32 + 16);
            if ((d0.x & d0.y & d0.z & d0.w & d1.x & d1.y & d1.z & d1.w) != 0u) break; }
    }
    if (TYPE == 1) __syncthreads();
    float inv = 1.f;
    if (TYPE == 0) { const float lt = lrun + __shfl_xor(lrun, 32); inv = 1.f / lt; }
    float ss = 0.f;
#pragma unroll
    for (int dt = 0; dt < 2; ++dt)
#pragma unroll
        for (int i = 0; i < 16; ++i) { const float v = oacc[dt][i] * inv; oacc[dt][i] = v; ss += v * v; }
    ss += __shfl_xor(ss, 32);
    float rs = 1.0f / sqrtf(ss * (1.f / 64.f) + RMS_EPS);
#if defined(DBG_ZERO_SB)
    if (TYPE == 1) rs = 0.f;
#endif
#if defined(DBG_ZERO_FOX)
    if (TYPE == 0) rs = 0.f;
#endif
    const float* g = (TYPE == 0 ? F.in[I_FOXG] : F.in[I_SBG]) + hh * 64;
    bf16_t* orow = o + (tok0 + qrow) * DM + hg * 64;
#pragma unroll
    for (int dt = 0; dt < 2; ++dt)
#pragma unroll
        for (int q = 0; q < 4; ++q) { const int d = 32 * dt + 8 * q + 4 * hf; const f32x4 gv = *(const GAS f32x4*)(g + d);
            u32x2 wv; wv.x = cvt_pk_bf16(oacc[dt][4 * q] * rs * gv[0], oacc[dt][4 * q + 1] * rs * gv[1]); wv.y = cvt_pk_bf16(oacc[dt][4 * q + 2] * rs * gv[2], oacc[dt][4 * q + 3] * rs * gv[3]);
            *(GAS u32x2*)(orow + d) = wv; }
}

__device__ __forceinline__ void phase_attn(Frame& F) {
    Cvt cv; cv.wge = F.in[I_WGE]; cv.wue = F.in[I_WUE]; cv.wde = F.in[I_WDE]; cv.wgu = (bf16_t*)(F.ws + WS_WGU); cv.wd = (bf16_t*)(F.ws + WS_WD);
    cv.e = F.bx; cv.r = F.wave; cv.pend = -1; cv.pend_e = 0;
#pragma unroll
    for (int i = 0; i < 8; ++i) cv.v[i] = (f32x4){0.f, 0.f, 0.f, 0.f};
    for (int p = F.vcu; p < 512; p += F.G) {
        const int type = p >> 8, combo = (p & 255) >> 3, qp = p & 7, b = combo >> 3, hh = combo & 7;
        if (type == 0) { attn_unit<0>(F, cv, b, hh, 15 - qp); attn_unit<0>(F, cv, b, hh, qp); }
        else { attn_unit<1>(F, cv, b, hh, 15 - qp); attn_unit<1>(F, cv, b, hh, qp); }
    }
    while (cv.e < NEXP || cv.pend >= 0) cvt_tick(cv, F.lane, F.G);
}

__device__ __forceinline__ void phase5(Frame& F) {
    const int gw = F.vcu * NWAVES + F.wave, NGW = F.G * NWAVES;
    float* x1 = (float*)(F.ws + WS_X1); bf16_t* u2 = (bf16_t*)(F.ws + WS_U2); const float* ada = (const float*)(F.ws + WS_ADA);
    const float* g1 = F.in[I_LN1G]; const float* b1 = F.in[I_LN1B];
    for (int m0 = gw; m0 < NTOK; m0 += 2 * NGW) {
        f32x4 v[2][4];
#pragma unroll
        for (int rr = 0; rr < 2; ++rr) { const int m = m0 + rr * NGW;
#pragma unroll
            for (int j = 0; j < 4; ++j) v[rr][j] = (m < NTOK) ? *(const GAS f32x4*)(x1 + (size_t)m * DM + 4 * F.lane + 256 * j) : (f32x4){0.f, 0.f, 0.f, 0.f}; }
        float s[2], s2[2];
#pragma unroll
        for (int rr = 0; rr < 2; ++rr) { s[rr] = 0.f;
#pragma unroll
            for (int j = 0; j < 4; ++j) s[rr] += (v[rr][j][0] + v[rr][j][1]) + (v[rr][j][2] + v[rr][j][3]); }
#pragma unroll
        for (int o = 1; o < 64; o <<= 1) { s[0] += __shfl_xor(s[0], o); s[1] += __shfl_xor(s[1], o); }
#pragma unroll
        for (int rr = 0; rr < 2; ++rr) { const float mean = s[rr] * (1.f / DM); s2[rr] = 0.f;
#pragma unroll
            for (int j = 0; j < 4; ++j) { v[rr][j] = v[rr][j] - mean; s2[rr] += (v[rr][j][0] * v[rr][j][0] + v[rr][j][1] * v[rr][j][1]) + (v[rr][j][2] * v[rr][j][2] + v[rr][j][3] * v[rr][j][3]); } }
#pragma unroll
        for (int o = 1; o < 64; o <<= 1) { s2[0] += __shfl_xor(s2[0], o); s2[1] += __shfl_xor(s2[1], o); }
#pragma unroll
        for (int rr = 0; rr < 2; ++rr) { const int m = m0 + rr * NGW; if (m >= NTOK) break;
            const int b = m >> 12; const float rstd = 1.f / sqrtf(s2[rr] * (1.f / DM) + LN_EPS);
#pragma unroll
            for (int j = 0; j < 4; ++j) { const int d = 4 * F.lane + 256 * j;
                const f32x4 gg = *(const GAS f32x4*)(g1 + d), bb = *(const GAS f32x4*)(b1 + d);
                const f32x4 xo = v[rr][j] * rstd * gg + bb; *(GAS f32x4*)(x1 + (size_t)m * DM + d) = xo;
                const f32x4 sc = *(const GAS f32x4*)(ada + b * 6144 + 4096 + d) + 1.0f, sh = *(const GAS f32x4*)(ada + b * 6144 + 3072 + d);
                const f32x4 u = xo * sc + sh;
                unsigned hb[4]; float lo[4];
#pragma unroll
                for (int q = 0; q < 4; ++q) { hb[q] = f2bf(u[q]); lo[q] = u[q] - bf2f(hb[q]); }
                u32x2 wh, wl; wh.x = hb[0] | (hb[1] << 16); wh.y = hb[2] | (hb[3] << 16); wl.x = pk2(lo[0], lo[1]); wl.y = pk2(lo[2], lo[3]);
                *(GAS u32x2*)(u2 + (size_t)m * 2048 + d) = wh; *(GAS u32x2*)(u2 + (size_t)m * 2048 + 1024 + d) = wl; } }
    }
}

__device__ __forceinline__ void phase7(Frame& F) {
    const int gw = F.vcu * NWAVES + F.wave, NGW = F.G * NWAVES, lane = F.lane;
    const float* lg = (const float*)(F.ws + WS_LOG); const float* rb = F.in[I_RB];
    unsigned* cnt = (unsigned*)(F.ws + WS_CTL) + CW_CNT; int* list = (int*)(F.ws + WS_LIST); float* topw = (float*)(F.ws + WS_TOPW); int* apos = (int*)(F.ws + WS_APOS);
    const f32x4 bias = *(const GAS f32x4*)(rb + 4 * lane);
    for (int t = gw; t < NTOK; t += NGW) {
        const size_t off = (size_t)t * NEXP + 4 * lane;
        const f32x4 l0 = *(const GAS f32x4*)(lg + off), l1 = *(const GAS f32x4*)(lg + (size_t)NTOK * NEXP + off), l2 = *(const GAS f32x4*)(lg + 2 * (size_t)NTOK * NEXP + off);
        float sc[4], sel[4];
#pragma unroll
        for (int i = 0; i < 4; ++i) { const float z = (l0[i] + l1[i]) + l2[i]; sc[i] = 1.f / (1.f + expf(-z)); sel[i] = sc[i] + bias[i]; }
        float a1 = fmaxf(sel[0], sel[1]), a2 = fminf(sel[0], sel[1]);
        { const float c1 = fmaxf(sel[2], sel[3]), c2 = fminf(sel[2], sel[3]); const float n1 = fmaxf(a1, c1), n2 = fmaxf(fminf(a1, c1), fmaxf(a2, c2)); a1 = n1; a2 = n2; }
#pragma unroll
        for (int o = 1; o < 8; o <<= 1) { const float b1v = __shfl_xor(a1, o), b2v = __shfl_xor(a2, o); const float n1 = fmaxf(a1, b1v), n2 = fmaxf(fminf(a1, b1v), fmaxf(a2, b2v)); a1 = n1; a2 = n2; }
        const float gs = a1 + a2; const int g = lane >> 3; int rank = 0;
#pragma unroll
        for (int gg = 0; gg < 8; ++gg) { const float o = __shfl(gs, gg * 8); rank += (o > gs || (o == gs && gg < g)) ? 1 : 0; }
        const bool gsel = rank < 4;
        float cand[4];
#pragma unroll
        for (int i = 0; i < 4; ++i) cand[i] = gsel ? sel[i] : -INFINITY;
        int my_e = 0; float my_w = 0.f, wsum = 0.f;
#pragma unroll
        for (int k = 0; k < TOPK; ++k) {
            float bv = cand[0]; int bi = 4 * lane;
#pragma unroll
            for (int i = 1; i < 4; ++i) if (cand[i] > bv) { bv = cand[i]; bi = 4 * lane + i; }
#pragma unroll
            for (int o = 32; o >= 1; o >>= 1) { const float ov = __shfl_xor(bv, o); const int oi = __shfl_xor(bi, o); if (ov > bv || (ov == bv && oi < bi)) { bv = ov; bi = oi; } }
            const int wl = bi >> 2, wi = bi & 3;
            float scw = sc[0]; scw = wi == 1 ? sc[1] : scw; scw = wi == 2 ? sc[2] : scw; scw = wi == 3 ? sc[3] : scw;
            scw = __shfl(scw, wl);
            if (lane == wl) {
#pragma unroll
                for (int i = 0; i < 4; ++i) if (i == wi) cand[i] = -INFINITY; }
            wsum += scw;
            if (lane == k) { my_e = bi; my_w = scw; }
        }
        if (lane < TOPK) { const int a = t * TOPK + lane; topw[a] = my_w / wsum * ROUTED_SCALE;
            const unsigned pos = atomicAdd(&cnt[my_e], 1u); list[(size_t)my_e * LIST_CAP + pos] = a; apos[a] = (my_e << 16) | (int)pos; }
    }
}

__device__ __forceinline__ int build_tile_table(Frame& F) {
    LAS int* ts = (LAS int*)(F.lds + TS_OFF); const unsigned* cnt = (const unsigned*)(F.ws + WS_CTL) + CW_CNT;
    __syncthreads();
    if (F.tid == 0) { int a = 0; for (int e = 0; e < NEXP; ++e) { ts[e] = a; a += ((int)__hip_atomic_load(cnt + e, RLX_AGENT) + 255) >> 8; } ts[NEXP] = a; }
    __syncthreads();
    return ts[NEXP];
}

__device__ __forceinline__ void phase10(Frame& F) {
    const int gw = F.vcu * NWAVES + F.wave, NGW = F.G * NWAVES;
    const float* x1 = (const float*)(F.ws + WS_X1); const bf16_t* y = (const bf16_t*)(F.ws + WS_Y); const bf16_t* ys = (const bf16_t*)(F.ws + WS_YS); const float* ada = (const float*)(F.ws + WS_ADA);
    const int* apos = (const int*)(F.ws + WS_APOS); const float* topw = (const float*)(F.ws + WS_TOPW); const LAS int* ts = (const LAS int*)(F.lds + TS_OFF);
    const float* g2 = F.in[I_LN2G]; const float* b2 = F.in[I_LN2B];
    int apn[TOPK]; float wkn[TOPK];
#pragma unroll
    for (int k = 0; k < TOPK; ++k) { apn[k] = gw < NTOK ? apos[gw * TOPK + k] : 0; wkn[k] = gw < NTOK ? topw[gw * TOPK + k] : 0.f; }
    for (int m = gw; m < NTOK; m += NGW) {
        const int b = m >> 12;
        size_t yrow[TOPK]; float wk[TOPK];
#pragma unroll
        for (int k = 0; k < TOPK; ++k) { const int ap = apn[k]; wk[k] = wkn[k]; yrow[k] = (size_t)(256 * ts[ap >> 16] + (ap & 0xffff)) * DM; }
        u32x2 yv[4][TOPK], sv[4]; f32x4 xv[4];
#pragma unroll
        for (int j = 0; j < 4; ++j) { const int d = 4 * F.lane + 256 * j;
#pragma unroll
            for (int k = 0; k < TOPK; ++k) yv[j][k] = *(const GAS u32x2*)(y + yrow[k] + d);
            sv[j] = *(const GAS u32x2*)(ys + (size_t)m * DM + d); xv[j] = *(const GAS f32x4*)(x1 + (size_t)m * DM + d); }
        { const int mn = m + NGW;
#pragma unroll
          for (int k = 0; k < TOPK; ++k) { apn[k] = mn < NTOK ? apos[mn * TOPK + k] : 0; wkn[k] = mn < NTOK ? topw[mn * TOPK + k] : 0.f; } }
        f32x4 v[4]; float s = 0.f;
#pragma unroll
        for (int j = 0; j < 4; ++j) { const int d = 4 * F.lane + 256 * j;
            f32x4 f = {bf2f(sv[j].x & 0xffffu), bf2f(sv[j].x >> 16), bf2f(sv[j].y & 0xffffu), bf2f(sv[j].y >> 16)};
#pragma unroll
            for (int k = 0; k < TOPK; ++k) { f[0] += wk[k] * bf2f(yv[j][k].x & 0xffffu); f[1] += wk[k] * bf2f(yv[j][k].x >> 16); f[2] += wk[k] * bf2f(yv[j][k].y & 0xffffu); f[3] += wk[k] * bf2f(yv[j][k].y >> 16); }
            const f32x4 gv = *(const GAS f32x4*)(ada + b * 6144 + 5120 + d) + 1.0f;
            v[j] = xv[j] * ALPHA + gv * f; s += (v[j][0] + v[j][1]) + (v[j][2] + v[j][3]); }
        const float mean = wave_sum(s) * (1.f / DM); float s2 = 0.f;
#pragma unroll
        for (int j = 0; j < 4; ++j) { v[j] = v[j] - mean; s2 += (v[j][0] * v[j][0] + v[j][1] * v[j][1]) + (v[j][2] * v[j][2] + v[j][3] * v[j][3]); }
        const float rstd = 1.f / sqrtf(wave_sum(s2) * (1.f / DM) + LN_EPS);
#pragma unroll
        for (int j = 0; j < 4; ++j) { const int d = 4 * F.lane + 256 * j; const f32x4 gg = *(const GAS f32x4*)(g2 + d), bb = *(const GAS f32x4*)(b2 + d);
            *(GAS f32x4*)(F.out + (size_t)m * DM + d) = v[j] * rstd * gg + bb; }
    }
}

__global__ void __launch_bounds__(NTHR, 2) fwd_kernel(Args args) {
    extern __shared__ __attribute__((aligned(16))) unsigned char lds_raw[];
    Frame F;
    F.lds = (LAS unsigned char*)lds_raw; F.ws = args.ws; F.in = args.in; F.out = args.out;
    F.tid = threadIdx.x; F.lane = F.tid & 63; F.wave = __builtin_amdgcn_readfirstlane(F.tid >> 6);
    F.G = gridDim.x; F.bx = blockIdx.x; F.vcu = (F.G % 8 == 0) ? (F.bx % 8) * (F.G / 8) + F.bx / 8 : F.bx;
    volatile LAS unsigned* MISC = (volatile LAS unsigned*)(F.lds + LDSCTL_OFF);
    for (int u = F.tid; u < 64; u += NTHR) MISC[u] = 0u;
    __syncthreads();
    unsigned* ctl = (unsigned*)(F.ws + WS_CTL);
    XcdBarrier bar = xcd_barrier_post(ctl + CW_BAR, MISC + 8);
    unsigned char* ws = F.ws;

    phase0(F);
    xcd_barrier(bar);
#if defined(DUP_P0)
    phase0(F);
    xcd_barrier(bar);
#endif
    phase1(F);
    xcd_barrier(bar);
#if defined(DUP_P1)
    phase1(F);
    xcd_barrier(bar);
#endif
    if (F.bx < 32) fcum_block(F, F.bx);
    __syncthreads();
    { ProbQK p; p.A = (const char*)(ws + WS_U1); p.B = (const char*)(ws + WS_WIN); p.K = DM; p.lda = 2048; p.ldb = 2048; p.G = F.G; p.c = F.bx; p.qk = (bf16_t*)(ws + WS_QK); pg8::gemm_phase(F.lds, p); }
    { ProbVT p; p.A = (const char*)(ws + WS_U1); p.B = (const char*)(ws + WS_WIN); p.K = DM; p.lda = 2048; p.ldb = 2048; p.G = F.G; p.c = F.bx; p.vt = (bf16_t*)(ws + WS_VT); pg8::gemm_phase(F.lds, p); }
    xcd_barrier(bar);
#if defined(DUP_P2)
    { ProbQK p; p.A = (const char*)(ws + WS_U1); p.B = (const char*)(ws + WS_WIN); p.K = DM; p.lda = 2048; p.ldb = 2048; p.G = F.G; p.c = F.bx; p.qk = (bf16_t*)(ws + WS_QK); pg8::gemm_phase(F.lds, p); }
    { ProbVT p; p.A = (const char*)(ws + WS_U1); p.B = (const char*)(ws + WS_WIN); p.K = DM; p.lda = 2048; p.ldb = 2048; p.G = F.G; p.c = F.bx; p.vt = (bf16_t*)(ws + WS_VT); pg8::gemm_phase(F.lds, p); }
    xcd_barrier(bar);
#endif
    phase_attn(F);
    xcd_barrier(bar);
#if defined(DUP_P3)
    phase_attn(F);
    xcd_barrier(bar);
#endif
    { ProbZ p; p.A = (const char*)(ws + WS_O); p.B = (const char*)(ws + WS_WOUT); p.K = DM; p.lda = 2048; p.ldb = 2048; p.G = F.G; p.c = F.bx; p.x = F.in[I_X]; p.ada = (const float*)(ws + WS_ADA); p.z = (float*)(ws + WS_X1); pg8::gemm_phase(F.lds, p); }
    xcd_barrier(bar);
#if defined(DUP_P4)
    { ProbZ p; p.A = (const char*)(ws + WS_O); p.B = (const char*)(ws + WS_WOUT); p.K = DM; p.lda = 2048; p.ldb = 2048; p.G = F.G; p.c = F.bx; p.x = F.in[I_X]; p.ada = (const float*)(ws + WS_ADA); p.z = (float*)(ws + WS_X1); pg8::gemm_phase(F.lds, p); }
    xcd_barrier(bar);
#endif
    phase5(F);
    xcd_barrier(bar);
#if defined(DBG_STOP5)
    { const f32x4* src = (const f32x4*)(ws + WS_X1); f32x4* dst = (f32x4*)F.out;
      for (size_t i = (size_t)F.bx * NTHR + F.tid; i < (size_t)NTOK * DM / 4; i += (size_t)F.G * NTHR) dst[i] = src[i]; }
    return;
#endif
    { ProbP6 p; p.A = (const char*)(ws + WS_U2); p.B = (const char*)(ws + WS_WR); p.K = DM; p.lda = 4096; p.ldb = 2048; p.G = F.G; p.c = F.vcu; p.logits = (float*)(ws + WS_LOG); p.hs = (bf16_t*)(ws + WS_HS); pg8::gemm_phase(F.lds, p); }
    xcd_barrier(bar);
#if defined(DUP_P6)
    { ProbP6 p; p.A = (const char*)(ws + WS_U2); p.B = (const char*)(ws + WS_WR); p.K = DM; p.lda = 4096; p.ldb = 2048; p.G = F.G; p.c = F.vcu; p.logits = (float*)(ws + WS_LOG); p.hs = (bf16_t*)(ws + WS_HS); pg8::gemm_phase(F.lds, p); }
    xcd_barrier(bar);
#endif
    phase7(F);
    xcd_barrier(bar);
    const int NT = build_tile_table(F);
    ExpTab T; T.ts = (const LAS int*)(F.lds + TS_OFF); T.NT = NT; T.cnt = (const unsigned*)(ws + WS_CTL) + CW_CNT; T.list = (const int*)(ws + WS_LIST);
    { ProbP8 p; p.A = (const char*)(ws + WS_U2); p.B = (const char*)(ws + WS_WGU); p.K = DM; p.lda = 4096; p.ldb = 2048; p.G = F.G; p.c = F.vcu; p.T = T; p.h = (bf16_t*)(ws + WS_H); pg8::gemm_phase(F.lds, p); }
    xcd_barrier(bar);
#if defined(DUP_P8)
    { ProbP8 p; p.A = (const char*)(ws + WS_U2); p.B = (const char*)(ws + WS_WGU); p.K = DM; p.lda = 4096; p.ldb = 2048; p.G = F.G; p.c = F.vcu; p.T = T; p.h = (bf16_t*)(ws + WS_H); pg8::gemm_phase(F.lds, p); }
    xcd_barrier(bar);
#endif
    { ProbP9 p; p.A = (const char*)(ws + WS_HS); p.B = (const char*)(ws + WS_WSD); p.K = DEXP; p.lda = 512; p.ldb = 512; p.G = F.G; p.c = F.vcu; p.T = T; p.topw = (const float*)(ws + WS_TOPW); p.y = (bf16_t*)(ws + WS_Y); p.ys = (bf16_t*)(ws + WS_YS); pg8::gemm_phase(F.lds, p); }
    xcd_barrier(bar);
#if defined(DUP_P9)
    { ProbP9 p; p.A = (const char*)(ws + WS_HS); p.B = (const char*)(ws + WS_WSD); p.K = DEXP; p.lda = 512; p.ldb = 512; p.G = F.G; p.c = F.vcu; p.T = T; p.topw = (const float*)(ws + WS_TOPW); p.y = (bf16_t*)(ws + WS_Y); p.ys = (bf16_t*)(ws + WS_YS); pg8::gemm_phase(F.lds, p); }
    xcd_barrier(bar);
#endif
#if defined(DUP_BAR)
    xcd_barrier(bar); xcd_barrier(bar); xcd_barrier(bar); xcd_barrier(bar); xcd_barrier(bar);
#endif
    phase10(F);
#if defined(DUP_P10)
    xcd_barrier(bar);
    phase10(F);
#endif
}

extern "C" void kernel_launch(void* const* d_in, const int* in_sizes, int n_in, void* d_out, int out_size, void* d_ws, size_t ws_size, hipStream_t stream) {
    static int grid = 0;
    if (grid == 0) {
        if (n_in != 21 || out_size != NTOK * DM || ws_size < WS_END) { fprintf(stderr, "kernel_launch: unexpected shapes (n_in %d out %d ws %zu)\n", n_in, out_size, ws_size); grid = -1; return; }
        int dev = 0, cus = 0, per_cu = 0;
        hipGetDevice(&dev); hipDeviceGetAttribute(&cus, hipDeviceAttributeMultiprocessorCount, dev);
        hipFuncSetAttribute((const void*)fwd_kernel, hipFuncAttributeMaxDynamicSharedMemorySize, LDS_BYTES);
        hipOccupancyMaxActiveBlocksPerMultiprocessor(&per_cu, (const void*)fwd_kernel, NTHR, LDS_BYTES);
        (void)hipGetLastError();
        if (per_cu < 1) { fprintf(stderr, "kernel_launch: occupancy query says %d blocks/CU\n", per_cu); }
        grid = cus < 256 ? cus : 256;
        grid -= grid % 8;
    }
    if (grid <= 0) return;
    hipMemsetAsync((char*)d_ws + WS_CTL, 0, CTL_ZERO_BYTES, stream);
    Args a{};
    for (int i = 0; i < 21; ++i) a.in[i] = (const float*)d_in[i];
    a.out = (float*)d_out; a.ws = (unsigned char*)d_ws;
    void* kargs[] = {&a};
    hipError_t e = hipLaunchCooperativeKernel((const void*)fwd_kernel, dim3(grid), dim3(NTHR), kargs, LDS_BYTES, stream);
    if (e != hipSuccess) fprintf(stderr, "kernel_launch: cooperative launch failed: %s (grid %d)\n", hipGetErrorString(e), grid);
}
```

```cpp
#include <hip/hip_runtime.h>
#include <cstdio>
#include <cstdint>

#define LAS __attribute__((address_space(3)))
#define GAS __attribute__((address_space(1)))
typedef unsigned short bf16_t;
typedef short bf16x8 __attribute__((ext_vector_type(8)));
typedef float f32x4 __attribute__((ext_vector_type(4)));
typedef float f32x16 __attribute__((ext_vector_type(16)));
typedef unsigned u32x4 __attribute__((ext_vector_type(4)));
typedef unsigned u32x2 __attribute__((ext_vector_type(2)));

constexpr int DM = 1024, NB = 4, SEQ = 4096, NTOK = NB * SEQ;
constexpr int NQKV = 3072, DIN = 3080, NEXP = 256, TOPK = 8, DEXP = 256;
constexpr float ALPHA = 1.189207115002721f;
constexpr float LN_EPS = 1e-5f, RMS_EPS = 1e-6f, ROUTED_SCALE = 2.5f;
constexpr float LOG2E = 1.4426950408889634f;
constexpr float QSCALE = 0.125f * LOG2E;
constexpr int LIST_CAP = NTOK;

constexpr size_t MiB = 1u << 20;
constexpr size_t WS_CTL = 0, CTL_ZERO_BYTES = 256 * 1024;
constexpr size_t WS_ADA = 1 * MiB;
constexpr size_t WS_WF = WS_ADA + 128 * 1024;
constexpr size_t WS_ADAP = 14 * MiB + 512 * 1024;
constexpr size_t WS_LOGF = 2 * MiB;
constexpr size_t WS_FCUM = WS_LOGF + 512 * 1024;
constexpr size_t WS_WIN = 3 * MiB;
constexpr size_t WS_WOUT = 9 * MiB;
constexpr size_t WS_WR = 11 * MiB;
constexpr size_t WS_WSGU = 12 * MiB;
constexpr size_t WS_WSD = 13 * MiB;
constexpr size_t WS_TOPW = 14 * MiB;
constexpr size_t WS_APOS = 15 * MiB + 512 * 1024;
constexpr size_t WS_X1 = 16 * MiB;
constexpr size_t WS_U2 = 80 * MiB;
constexpr size_t WS_HS = 144 * MiB;
constexpr size_t WS_LIST = 152 * MiB;
constexpr size_t WS_H = 176 * MiB;
constexpr size_t WS_YS = 280 * MiB;
constexpr size_t WS_Y = 312 * MiB;
constexpr size_t WS_U1 = 312 * MiB;
constexpr size_t WS_QK = 344 * MiB;
constexpr size_t WS_VT = 440 * MiB;
constexpr size_t WS_O = 472 * MiB;
constexpr size_t WS_LOG = 504 * MiB;
constexpr size_t WS_WGU = 568 * MiB;
constexpr size_t WS_WD = 824 * MiB;
constexpr size_t WS_END = 952 * MiB;
constexpr int CW_CNT = 1024;
constexpr int CW_BAR = 4096;

constexpr int RING_BYTES = 131072;
constexpr int LDSCTL_OFF = RING_BYTES;
constexpr int TS_OFF = RING_BYTES + 256;
constexpr int LDS_BYTES = 147456;
constexpr int NWAVES = 8, NTHR = 512;

#define RLX_AGENT __ATOMIC_RELAXED, __HIP_MEMORY_SCOPE_AGENT
#define LDS_WAIT() asm volatile("s_waitcnt lgkmcnt(0)" ::: "memory")
#define VM_WAIT() asm volatile("s_waitcnt vmcnt(0)" ::: "memory")
__device__ __forceinline__ unsigned f2bf(float f) { unsigned u = __builtin_bit_cast(unsigned, f); return (u + 0x7fffu + ((u >> 16) & 1u)) >> 16; }
__device__ __forceinline__ unsigned pk2(float lo, float hi) { return f2bf(lo) | (f2bf(hi) << 16); }
__device__ __forceinline__ float bf2f(unsigned h) { return __builtin_bit_cast(float, h << 16); }
typedef __bf16 bf16x2_t __attribute__((ext_vector_type(2)));
typedef float f32x2_t __attribute__((ext_vector_type(2)));
__device__ __forceinline__ unsigned cvt_pk_bf16(float lo, float hi) { const f32x2_t v = {lo, hi}; const bf16x2_t r = __builtin_convertvector(v, bf16x2_t); return __builtin_bit_cast(unsigned, r); }
__device__ __forceinline__ float wave_sum(float v) {
#pragma unroll
    for (int o = 1; o < 64; o <<= 1) v += __shfl_xor(v, o);
    return v;
}

#define XB_TMO      128
#define XB_XCNT(j)  (256  + 64 * (j))
#define XB_XSUB(j)  (1280 + 64 * (j))
#define XB_XGEN(j)  (2304 + 64 * (j))
#define XB_TOP      3328
#define XB_TOPGEN   3392
#define XCD_BAR_WORDS 3456
#define XB_SPIN_CAP (1u << 18)
__device__ __forceinline__ unsigned xb_ld(unsigned* p)              { return __hip_atomic_load(p, __ATOMIC_RELAXED, __HIP_MEMORY_SCOPE_AGENT); }
__device__ __forceinline__ unsigned xb_add(unsigned* p, unsigned v) { return __hip_atomic_fetch_add(p, v, __ATOMIC_RELAXED, __HIP_MEMORY_SCOPE_AGENT); }
__device__ __forceinline__ unsigned xb_xcc_id() { return (unsigned)__builtin_amdgcn_s_getreg((3 << 11) | 20) & 0xFu; }
#define XB_SPIN(cond, bar) do { unsigned _sp = 0; while (cond) { __builtin_amdgcn_s_sleep(1); \
    if ((++_sp & 255u) == 0u) { if (xb_ld(&(bar)[XB_TMO])) break; if (_sp > XB_SPIN_CAP) { atomicAdd(&(bar)[XB_TMO], 1u); break; } } } } while (0)
struct XcdBarrier { unsigned* bar; unsigned x; volatile LAS unsigned* st; };
__device__ __forceinline__ XcdBarrier xcd_barrier_post(unsigned* bar, volatile LAS unsigned* st) {
    XcdBarrier b; b.bar = bar; b.x = xb_xcc_id(); b.st = st;
    if (threadIdx.x == 0) (void)xb_add(&bar[XB_XCNT(b.x)], 1u);
    return b;
}
__device__ __forceinline__ void xcd_barrier_complete(unsigned* bar, unsigned x, unsigned& nloc, unsigned& nx) {
    const unsigned G = gridDim.x * gridDim.y * gridDim.z;
    unsigned sum, cnt, mine, sp = 0u;
    for (;;) {
        sum = 0u; cnt = 0u; mine = 0u;
#pragma unroll
        for (unsigned j = 0; j < 16; ++j) { const unsigned c = xb_ld(&bar[XB_XCNT(j)]); sum += c; cnt += (c > 0u) ? 1u : 0u; mine = (j == x) ? c : mine; }
        if (sum == G) break;
        __builtin_amdgcn_s_sleep(1);
        if ((++sp & 255u) == 0u) { if (xb_ld(&bar[XB_TMO])) break; if (sp > XB_SPIN_CAP) { atomicAdd(&bar[XB_TMO], 1u); break; } }
    }
    nloc = mine > 0u ? mine : 1u; nx = cnt > 0u ? cnt : 1u;
}
__device__ __forceinline__ void xcd_barrier(const XcdBarrier& b) {
    asm volatile("s_waitcnt vmcnt(0)" ::: "memory");
    __syncthreads();
    if (threadIdx.x == 0) {
        unsigned* bar = b.bar;
        __builtin_amdgcn_s_waitcnt(0);
        unsigned nloc = b.st[0], nx = b.st[1];
        if (nloc == 0u) { xcd_barrier_complete(bar, b.x, nloc, nx); b.st[0] = nloc; b.st[1] = nx; }
        const unsigned old = xb_add(&bar[XB_XSUB(b.x)], 1u);
        const unsigned gen = old / nloc;
        if (old + 1u == (gen + 1u) * nloc) {
            __builtin_amdgcn_fence(__ATOMIC_RELEASE, "agent");
            asm volatile("s_waitcnt vmcnt(0)" ::: "memory");
            const unsigned og = xb_add(&bar[XB_TOP], 1u);
            const unsigned tg = og / nx;
            if (og + 1u == (tg + 1u) * nx) xb_add(&bar[XB_TOPGEN], 1u);
            else XB_SPIN(xb_ld(&bar[XB_TOPGEN]) == tg, bar);
            __builtin_amdgcn_fence(__ATOMIC_ACQUIRE, "agent");
            xb_add(&bar[XB_XGEN(b.x)], 1u);
            asm volatile("s_waitcnt vmcnt(0)" ::: "memory");
        } else {
            XB_SPIN(xb_ld(&bar[XB_XGEN(b.x)]) == gen, bar);
            __builtin_amdgcn_fence(__ATOMIC_ACQUIRE, "agent");
            asm volatile("s_waitcnt vmcnt(0)" ::: "memory");
        }
    }
    __syncthreads();
}

namespace pg8 {
constexpr int BM = 256, BK = 64, HALF = 128, HTB = HALF * BK * 2, STAGE_BYTES = 8 * HTB;
__device__ __forceinline__ int lds_byte(int r, int c) { const int st = (r >> 4) * 2 + (c >> 5), rr = r & 15, cc = c & 31, ob = rr * 64 + cc * 2; return st * 1024 + (ob ^ (((ob >> 9) & 1) << 5)); }
__device__ __forceinline__ void stage_rc(int b, int& R, int& C) { const int st = b / 1024, sb = b % 1024, swz = sb ^ (((sb >> 9) & 1) << 5); R = (st >> 1) * 16 + swz / 64; C = (st & 1) * 32 + (swz % 64) / 2; }
__device__ __forceinline__ int perm32(int rho) { const int n = rho >> 4, i = rho & 15; return 8 * (i >> 2) + 4 * n + (i & 3); }

struct Unit { int pm, pn, e, cnt; };

template <class P>
__device__ __forceinline__ void gemm_phase(LAS unsigned char* lds, const P& prob) {
    int tid_ = threadIdx.x; asm volatile("" : "+v"(tid_));
    const int tid = tid_, wid = __builtin_amdgcn_readfirstlane(tid >> 6), lane = tid & 63, wr = wid >> 2, wc = wid & 3, fr = lane & 15, fq = lane >> 4;
    const int nt = prob.K / BK;
    int Rr[2]; unsigned voffA[2], voffB[2];
#pragma unroll
    for (int i = 0; i < 2; ++i) { int R, C; stage_rc(tid * 16 + i * 8192, R, C); Rr[i] = R; const int Rb = P::PERM ? ((R & ~31) + perm32(R & 31)) : R;
        voffA[i] = P::GATHER ? (unsigned)(C * 2) : (unsigned)(R * prob.lda + C * 2); voffB[i] = (unsigned)(Rb * prob.ldb + C * 2); }
    const size_t kstep = (size_t)(BK * 2);
    const size_t hA = P::GATHER ? 0 : (size_t)HALF * prob.lda, hB = (size_t)HALF * prob.ldb;
    const unsigned ldsw = (unsigned)wid * 1024u;
    const int aoff = lds_byte(wr * 64 + fr, fq * 8), boff = lds_byte(wc * 32 + fr, fq * 8);
#define PG8_SA(b, h) (((b) * 2 + (h)) * HTB)
#define PG8_SB(b, h) ((4 + (b) * 2 + (h)) * HTB)
#define PG8_STAGE(bufoff, gbase, voff) do { _Pragma("unroll") for (int _i = 0; _i < 2; ++_i) \
        __builtin_amdgcn_global_load_lds((const unsigned*)((const char*)(gbase) + (voff)[_i]), (LAS unsigned*)(lds + (bufoff) + ldsw + _i * 8192), 16, 0, 0); } while (0)
#define PG8_LDA(dst, b, h) do { _Pragma("unroll") for (int m = 0; m < 4; ++m) _Pragma("unroll") for (int k = 0; k < 2; ++k) dst[m][k] = *(const LAS bf16x8*)(lds + PG8_SA(b, h) + aoff + m * 2048 + k * 1024); } while (0)
#define PG8_LDB(dst, b, h) do { _Pragma("unroll") for (int n = 0; n < 2; ++n) _Pragma("unroll") for (int k = 0; k < 2; ++k) dst[n][k] = *(const LAS bf16x8*)(lds + PG8_SB(b, h) + boff + n * 2048 + k * 1024); } while (0)
#define PG8_MMA(ai, bj, At, Bt) do { __builtin_amdgcn_s_setprio(1); _Pragma("unroll") for (int m = 0; m < 4; ++m) _Pragma("unroll") for (int n = 0; n < 2; ++n) _Pragma("unroll") for (int k = 0; k < 2; ++k) \
        acc[ai][bj][m][n] = P::SWAP ? __builtin_amdgcn_mfma_f32_16x16x32_bf16(At[m][k], Bt[n][k], acc[ai][bj][m][n], 0, 0, 0) \
                                    : __builtin_amdgcn_mfma_f32_16x16x32_bf16(Bt[n][k], At[m][k], acc[ai][bj][m][n], 0, 0, 0); __builtin_amdgcn_s_setprio(0); } while (0)
#define PG8_WAIT_V(n) asm volatile("s_waitcnt vmcnt(" #n ")" ::: "memory")
#define PG8_WAIT_L(n) asm volatile("s_waitcnt lgkmcnt(" #n ")" ::: "memory")
#define PG8_BAR __builtin_amdgcn_s_barrier()
#define PG8_SCHED __builtin_amdgcn_sched_barrier(0)
#define PG8_STAGE_A(bufoff, base, kb, h, og) do { if constexpr (P::GATHER) { unsigned _v[2] = {og[h][0] + voffA[0], og[h][1] + voffA[1]}; PG8_STAGE(bufoff, gA + (kb), _v); } \
        else { PG8_STAGE(bufoff, gA + (base) + (kb) + (h) * hA, voffA); } } while (0)
#define PG8_STAGE_B(bufoff, base, kb, h) PG8_STAGE(bufoff, gB + (base) + (kb) + (h) * hB, voffB)
#define PG8_GOFFS(u, og) do { if constexpr (P::GATHER) { _Pragma("unroll") for (int _h = 0; _h < 2; ++_h) _Pragma("unroll") for (int _i = 0; _i < 2; ++_i) og[_h][_i] = prob.a_row(u, _h * HALF + Rr[_i]); } } while (0)
    Unit cur, nxt; int ui = 0;
    if (!prob.next(0, cur)) return;
    f32x4 acc[2][2][4][2];
#pragma unroll
    for (int a = 0; a < 2; ++a)
#pragma unroll
        for (int b = 0; b < 2; ++b)
#pragma unroll
            for (int m = 0; m < 4; ++m)
#pragma unroll
                for (int n = 0; n < 2; ++n) acc[a][b][m][n] = (f32x4){0.f, 0.f, 0.f, 0.f};
    bf16x8 At[4][2], B0[2][2], B1[2][2];
    unsigned ogc[2][2] = {{0u, 0u}, {0u, 0u}}, ogn[2][2] = {{0u, 0u}, {0u, 0u}};
    PG8_GOFFS(cur, ogc);
    const char* const gA = prob.A; const char* const gB = prob.B;
    size_t cAb = P::GATHER ? 0 : prob.a_base(cur), cBb = prob.b_base(cur);
    PG8_STAGE_B(PG8_SB(0, 0), cBb, 0, 0); PG8_STAGE_B(PG8_SB(0, 1), cBb, 0, 1); PG8_STAGE_A(PG8_SA(0, 0), cAb, 0, 0, ogc); PG8_STAGE_A(PG8_SA(0, 1), cAb, 0, 1, ogc);
    if (wr == 1) PG8_BAR;
    PG8_WAIT_V(2); PG8_BAR;
    PG8_STAGE_B(PG8_SB(1, 0), cBb, kstep, 0); PG8_STAGE_A(PG8_SA(1, 0), cAb, kstep, 0, ogc); PG8_STAGE_B(PG8_SB(1, 1), cBb, kstep, 1);
    PG8_WAIT_V(6); PG8_BAR;
    for (;;) {
        const bool has_next = prob.next(ui + 1, nxt);
        size_t nAb = cAb, nBb = cBb;
        if (has_next) { nAb = P::GATHER ? 0 : prob.a_base(nxt); nBb = prob.b_base(nxt); }
        for (int t = 0; t < nt; t += 2) {
            const bool last = (t == nt - 2);
            const size_t k1 = (size_t)(t + 1) * kstep;
            const size_t k2 = last ? 0 : (size_t)(t + 2) * kstep, k3 = k2 + kstep;
            const size_t a2 = last ? nAb : cAb, b2 = last ? nBb : cBb;
            if constexpr (P::GATHER) if (last) { if (has_next) { PG8_GOFFS(nxt, ogn); } else {
#pragma unroll
                for (int h = 0; h < 2; ++h)
#pragma unroll
                    for (int i = 0; i < 2; ++i) ogn[h][i] = ogc[h][i]; } }
            unsigned og2[2][2];
#pragma unroll
            for (int h = 0; h < 2; ++h)
#pragma unroll
                for (int i = 0; i < 2; ++i) og2[h][i] = (P::GATHER && last) ? ogn[h][i] : ogc[h][i];
            PG8_LDB(B0, 0, 0); PG8_LDB(B1, 0, 1); PG8_SCHED; PG8_LDA(At, 0, 0); PG8_STAGE_A(PG8_SA(1, 1), cAb, k1, 1, ogc);
            PG8_WAIT_V(8); PG8_WAIT_L(0); PG8_BAR; PG8_MMA(0, 0, At, B0); PG8_MMA(0, 1, At, B1); PG8_BAR; PG8_SCHED;
            PG8_LDA(At, 0, 1); PG8_STAGE_B(PG8_SB(0, 0), b2, k2, 0); PG8_STAGE_B(PG8_SB(0, 1), b2, k2, 1); PG8_STAGE_A(PG8_SA(0, 0), a2, k2, 0, og2);
            PG8_WAIT_V(8); PG8_WAIT_L(0); PG8_BAR; PG8_MMA(1, 0, At, B0); PG8_MMA(1, 1, At, B1); PG8_BAR; PG8_SCHED;
            PG8_LDB(B0, 1, 0); PG8_LDB(B1, 1, 1); PG8_SCHED; PG8_LDA(At, 1, 0); PG8_STAGE_A(PG8_SA(0, 1), a2, k2, 1, og2);
            PG8_WAIT_V(8); PG8_WAIT_L(0); PG8_BAR; PG8_MMA(0, 0, At, B0); PG8_MMA(0, 1, At, B1); PG8_BAR; PG8_SCHED;
            PG8_LDA(At, 1, 1); PG8_STAGE_B(PG8_SB(1, 0), b2, k3, 0); PG8_STAGE_B(PG8_SB(1, 1), b2, k3, 1); PG8_STAGE_A(PG8_SA(1, 0), a2, k3, 0, og2);
            PG8_WAIT_V(8); PG8_WAIT_L(0); PG8_BAR; PG8_MMA(1, 0, At, B0); PG8_MMA(1, 1, At, B1); PG8_BAR; PG8_SCHED;
        }
        if (wr == 0) PG8_BAR;
        prob.epi(acc, cur, wr, wc, fr, fq);
        if (!has_next) break;
#pragma unroll
        for (int a = 0; a < 2; ++a)
#pragma unroll
            for (int b = 0; b < 2; ++b)
#pragma unroll
                for (int m = 0; m < 4; ++m)
#pragma unroll
                    for (int n = 0; n < 2; ++n) acc[a][b][m][n] = (f32x4){0.f, 0.f, 0.f, 0.f};
        cur = nxt; ++ui; cAb = nAb; cBb = nBb;
#pragma unroll
        for (int h = 0; h < 2; ++h)
#pragma unroll
            for (int i = 0; i < 2; ++i) ogc[h][i] = ogn[h][i];
        if (wr == 1) PG8_BAR;
    }
    PG8_WAIT_V(0);
    PG8_BAR;
#undef PG8_SA
#undef PG8_SB
#undef PG8_STAGE
#undef PG8_STAGE_A
#undef PG8_STAGE_B
#undef PG8_GOFFS
#undef PG8_LDA
#undef PG8_LDB
#undef PG8_MMA
#undef PG8_WAIT_V
#undef PG8_WAIT_L
#undef PG8_BAR
#undef PG8_SCHED
}
}
using pg8::Unit;

__device__ __forceinline__ bool static_tile(int i, int G, int c, int nM, int nN, int& pm, int& pn) {
    const int nwg = nM * nN; const long L = (long)i * G + c; if (L >= nwg) return false;
    int wgid = (int)L; { const int q = nwg / 8, r = nwg % 8, xcd = wgid % 8, off = wgid / 8; wgid = (xcd < r ? xcd * (q + 1) : r * (q + 1) + (xcd - r) * q) + off; }
    const int WGM = 8, nig = WGM * nN, gid = wgid / nig, fm = gid * WGM, gsz = (nM - fm) < WGM ? (nM - fm) : WGM;
    pm = fm + ((wgid % nig) % gsz); pn = (wgid % nig) / gsz; return true;
}

struct Args { const float* in[21]; float* out; unsigned char* ws; };
struct Frame {
    LAS unsigned char* lds; unsigned char* ws; const float* const* in; float* out;
    int tid, lane, wave, G, vcu, bx;
};
__device__ __forceinline__ void frame_refresh(Frame& F) {
    int t = threadIdx.x; asm volatile("" : "+v"(t)); F.tid = t; F.lane = t & 63; F.wave = __builtin_amdgcn_readfirstlane(t >> 6);
}
enum { I_X = 0, I_C, I_WADA, I_BADA, I_WIN, I_BF, I_FOXG, I_SBG, I_WOUT, I_LN1G, I_LN1B, I_WR, I_RB, I_WGE, I_WUE, I_WDE, I_WGS, I_WUS, I_WDS, I_LN2G, I_LN2B };

__device__ __forceinline__ void transpose_item(const float* W, int ldw, int k0, int nsrc0, bf16_t* WT, bf16_t* WT_lo, int Kd, int drow0, LAS float* scr, int lane) {
#pragma unroll 8
    for (int i = 0; i < 32; ++i) { const int kk = 2 * i + (lane >> 5); scr[kk * 33 + (lane & 31)] = W[(size_t)(k0 + kk) * ldw + nsrc0 + (lane & 31)]; }
    LDS_WAIT(); asm volatile("" ::: "memory");
    const int c = lane & 7;
#pragma unroll
    for (int j = 0; j < 4; ++j) { const int n = (lane >> 3) + 8 * j; const LAS float* s = scr + (8 * c) * 33 + n;
        float v[8];
#pragma unroll
        for (int q = 0; q < 8; ++q) v[q] = s[q * 33];
        u32x4 o; o.x = pk2(v[0], v[1]); o.y = pk2(v[2], v[3]); o.z = pk2(v[4], v[5]); o.w = pk2(v[6], v[7]);
        *(GAS u32x4*)(WT + (size_t)(drow0 + n) * Kd + k0 + 8 * c) = o;
        if (WT_lo) {
            float r[8];
#pragma unroll
            for (int q = 0; q < 8; ++q) r[q] = v[q] - bf2f(f2bf(v[q]));
            u32x4 p; p.x = pk2(r[0], r[1]); p.y = pk2(r[2], r[3]); p.z = pk2(r[4], r[5]); p.w = pk2(r[6], r[7]);
            *(GAS u32x4*)(WT_lo + (size_t)(drow0 + n) * Kd + k0 + 8 * c) = p;
        } }
    LDS_WAIT(); asm volatile("" ::: "memory");
}

__device__ __forceinline__ void phase0(Frame& F) {
    frame_refresh(F);
    const int gw = F.vcu * NWAVES + F.wave, NGW = F.G * NWAVES;
    unsigned char* ws = F.ws;
    LAS float* sc = (LAS float*)(F.lds);
    for (int i = F.tid; i < NB * DM; i += NTHR) { const float v = F.in[I_C][i]; sc[i] = v / (1.f + __expf(-v)); }
    __syncthreads();
    if (gw < 192) {
        const int nc = gw % 24, kq = gw / 24; const float* W = F.in[I_WADA];
        f32x4 a[4];
#pragma unroll
        for (int b = 0; b < 4; ++b) a[b] = (f32x4){0.f, 0.f, 0.f, 0.f};
        const int col = nc * 256 + F.lane * 4;
#pragma unroll 16
        for (int k = kq * 128; k < kq * 128 + 128; ++k) {
            const f32x4 w = *(const GAS f32x4*)(W + (size_t)k * 6144 + col);
#pragma unroll
            for (int b = 0; b < 4; ++b) a[b] += w * sc[b * DM + k];
        }
        float* part = (float*)(ws + WS_ADAP);
#pragma unroll
        for (int b = 0; b < 4; ++b) *(GAS f32x4*)(part + ((size_t)kq * 4 + b) * 6144 + col) = a[b];
    }
    { float* wf = (float*)(ws + WS_WF); const float* W = F.in[I_WIN];
      for (int i = F.bx * NTHR + F.tid; i < 8 * DM; i += F.G * NTHR) { const int hh = i >> 10, k = i & 1023; wf[i] = W[(size_t)k * DIN + NQKV + hh]; } }
    LAS float* scr = (LAS float*)(F.lds + 16384 + F.wave * 12288);
    bf16_t* win = (bf16_t*)(ws + WS_WIN); bf16_t* wout = (bf16_t*)(ws + WS_WOUT); bf16_t* wr = (bf16_t*)(ws + WS_WR);
    bf16_t* wsgu = (bf16_t*)(ws + WS_WSGU); bf16_t* wsd = (bf16_t*)(ws + WS_WSD); bf16_t* wgu = (bf16_t*)(ws + WS_WGU); bf16_t* wd = (bf16_t*)(ws + WS_WD);
    constexpr int I_IN = 16 * 96, I_OUT = 16 * 32, I_R = 16 * 8, I_SGU = 16 * 16, I_SD = 4 * 32, I_SMALL = I_IN + I_OUT + I_R + I_SGU + I_SD;
    constexpr int I_EGU = 16 * 16, I_ED = 4 * 32, I_E = I_EGU + I_ED;
    const int NITEMS = I_SMALL;
    for (int it = gw; it < NITEMS; it += NGW) {
        int r = it;
        if (r < I_IN) { const int kb = r / 96, nb = r % 96; transpose_item(F.in[I_WIN], DIN, 64 * kb, 32 * nb, win, nullptr, DM, 32 * nb, scr, F.lane); continue; } r -= I_IN;
        if (r < I_OUT) { const int kb = r / 32, nb = r % 32; transpose_item(F.in[I_WOUT], DM, 64 * kb, 32 * nb, wout, nullptr, DM, 32 * nb, scr, F.lane); continue; } r -= I_OUT;
        if (r < I_R) { const int kb = r / 8, nb = r % 8; transpose_item(F.in[I_WR], NEXP, 64 * kb, 32 * nb, wr, wr + NEXP * DM, DM, 32 * nb, scr, F.lane); continue; } r -= I_R;
        if (r < I_SGU) { const int kb = r / 16, nb = r % 16, ct = nb >> 3, half = (nb >> 2) & 1, jb = nb & 3;
            transpose_item(half ? F.in[I_WUS] : F.in[I_WGS], DEXP, 64 * kb, 128 * ct + 32 * jb, wsgu, nullptr, DM, 32 * nb, scr, F.lane); continue; } r -= I_SGU;
        if (r < I_SD) { const int kb = r / 32, nb = r % 32; transpose_item(F.in[I_WDS], DM, 64 * kb, 32 * nb, wsd, nullptr, DEXP, 32 * nb, scr, F.lane); continue; } r -= I_SD;
        const int e = r / I_E; r -= e * I_E;
        if (r < I_EGU) { const int kb = r / 16, nb = r % 16, ct = nb >> 3, half = (nb >> 2) & 1, jb = nb & 3;
            const float* src = (half ? F.in[I_WUE] : F.in[I_WGE]) + (size_t)e * DM * DEXP;
            transpose_item(src, DEXP, 64 * kb, 128 * ct + 32 * jb, wgu + (size_t)e * 512 * DM, nullptr, DM, 32 * nb, scr, F.lane); continue; } r -= I_EGU;
        { const int kb = r / 32, nb = r % 32; transpose_item(F.in[I_WDE] + (size_t)e * DEXP * DM, DM, 64 * kb, 32 * nb, wd + (size_t)e * DM * DEXP, nullptr, DEXP, 32 * nb, scr, F.lane); }
    }
}

__device__ __forceinline__ float ada_from_partials(const float* part, const float* bada, int b, int j) {
    float a = 0.f;
#pragma unroll
    for (int q = 0; q < 8; ++q) a += part[(q * 4 + b) * 6144 + j];
    return bada[j] + a;
}
__device__ __forceinline__ void phase1(Frame& F) {
    frame_refresh(F);
    unsigned char* ws = F.ws; const float* part = (const float*)(ws + WS_ADAP); const float* bada = F.in[I_BADA];
    LAS float* tab = (LAS float*)F.lds;
    LAS float* wfl = (LAS float*)(F.lds + 32768);
    for (int i = F.tid; i < NB * 2 * DM; i += NTHR) { const int b = i >> 11, which = (i >> 10) & 1, d = i & 1023;
        const float v = ada_from_partials(part, bada, b, (which == 0 ? 1024 : 0) + d); tab[i] = which == 0 ? 1.f + v : v; }
    { const float* wf = (const float*)(ws + WS_WF); for (int i = F.tid; i < 8 * DM; i += NTHR) wfl[i] = wf[i]; }
    { float* ada = (float*)(ws + WS_ADA);
      for (int j = F.bx * NTHR + F.tid; j < NB * 6144; j += F.G * NTHR) ada[j] = ada_from_partials(part, bada, j / 6144, j % 6144); }
    __syncthreads();
    const int gw = F.vcu * NWAVES + F.wave, NGW = F.G * NWAVES;
    const float* x = F.in[I_X]; bf16_t* u1 = (bf16_t*)(ws + WS_U1); float* logf = (float*)(ws + WS_LOGF);
    const float bfv = F.in[I_BF][F.lane & 7];
    for (int m0 = gw; m0 < NTOK; m0 += 2 * NGW) {
        f32x4 xv[2][4];
#pragma unroll
        for (int rr = 0; rr < 2; ++rr) { const int m = m0 + rr * NGW;
#pragma unroll
            for (int j = 0; j < 4; ++j) xv[rr][j] = (m < NTOK) ? *(const GAS f32x4*)(x + (size_t)m * DM + 4 * F.lane + 256 * j) : (f32x4){0.f, 0.f, 0.f, 0.f}; }
#pragma unroll
        for (int rr = 0; rr < 2; ++rr) { const int m = m0 + rr * NGW; if (m >= NTOK) break;
            const int b = m >> 12, s = m & 4095;
            f32x4 u[4];
#pragma unroll
            for (int j = 0; j < 4; ++j) { const int d = 4 * F.lane + 256 * j;
                const f32x4 sc = *(const LAS f32x4*)(tab + (b * 2 + 0) * DM + d), sh = *(const LAS f32x4*)(tab + (b * 2 + 1) * DM + d);
                u[j] = xv[rr][j] * sc + sh;
                u32x2 w; w.x = pk2(u[j][0], u[j][1]); w.y = pk2(u[j][2], u[j][3]); *(GAS u32x2*)(u1 + (size_t)m * DM + d) = w; }
            float fl[8];
#pragma unroll
            for (int hh = 0; hh < 8; ++hh) { float a = 0.f;
#pragma unroll
                for (int j = 0; j < 4; ++j) { const f32x4 w = *(const LAS f32x4*)(wfl + hh * DM + 4 * F.lane + 256 * j); a += (u[j][0] * w[0] + u[j][1] * w[1]) + (u[j][2] * w[2] + u[j][3] * w[3]); }
                fl[hh] = a; }
#pragma unroll
            for (int o = 1; o < 64; o <<= 1) {
#pragma unroll
                for (int hh = 0; hh < 8; ++hh) fl[hh] += __shfl_xor(fl[hh], o); }
            if (F.lane < 8) { float v = 0.f;
#pragma unroll
                for (int hh = 0; hh < 8; ++hh) v = (F.lane == hh) ? fl[hh] : v;
                v += bfv;
                const float ls = fminf(v, 0.f) - log1pf(expf(-fabsf(v)));
                logf[((size_t)(b * 8 + F.lane)) * SEQ + s] = ls * LOG2E; }
        }
    }
}

__device__ __forceinline__ void fcum_block(Frame& F, int seq) {
    frame_refresh(F);
    const float* logf = (const float*)(F.ws + WS_LOGF) + (size_t)seq * SEQ; float* fc = (float*)(F.ws + WS_FCUM) + (size_t)seq * SEQ;
    LAS float* part = (LAS float*)F.lds;
    float v[8]; float run = 0.f;
#pragma unroll
    for (int i = 0; i < 8; ++i) { run += logf[F.tid * 8 + i]; v[i] = run; }
    part[F.tid] = run; __syncthreads();
    if (F.tid == 0) { float a = 0.f; for (int i = 0; i < NTHR; ++i) { const float t = part[i]; part[i] = a; a += t; } }
    __syncthreads();
    const float base = part[F.tid];
#pragma unroll
    for (int i = 0; i < 8; ++i) fc[F.tid * 8 + i] = base + v[i];
    __syncthreads();
}

struct ProbQK {
    static constexpr bool PERM = true, SWAP = false, GATHER = false;
    const char* A; const char* B; int K, lda, ldb; int G, c; bf16_t* qk;
    __device__ __forceinline__ bool next(int i, Unit& u) const { int pm, pn; if (!static_tile(i, G, c, 64, 8, pm, pn)) return false; u.pm = pm; u.pn = pn < 4 ? pn : pn + 2; u.e = -1; u.cnt = 0; return true; }
    __device__ __forceinline__ size_t a_base(const Unit& u) const { return (size_t)(u.pm * 256) * 2048u; }
    __device__ __forceinline__ size_t b_base(const Unit& u) const { return (size_t)(u.pn * 256) * 2048u; }
    __device__ __forceinline__ void epi(const f32x4 (&acc)[2][2][4][2], const Unit& u, int wr, int wc, int fr, int fq) const {
        const float sc = (u.pn == 0 || u.pn == 1 || u.pn == 6 || u.pn == 7) ? QSCALE : 1.f;
#pragma unroll
        for (int ai = 0; ai < 2; ++ai)
#pragma unroll
            for (int m = 0; m < 4; ++m) { bf16_t* rowp = qk + (size_t)(u.pm * 256 + ai * 128 + wr * 64 + m * 16 + fr) * NQKV + u.pn * 256 + wc * 32 + 8 * fq;
#pragma unroll
                for (int bj = 0; bj < 2; ++bj) { const f32x4 v0 = acc[ai][bj][m][0] * sc, v1 = acc[ai][bj][m][1] * sc; u32x4 w;
                    w.x = cvt_pk_bf16(v0[0], v0[1]); w.y = cvt_pk_bf16(v0[2], v0[3]); w.z = cvt_pk_bf16(v1[0], v1[1]); w.w = cvt_pk_bf16(v1[2], v1[3]);
                    *(GAS u32x4*)(rowp + bj * 128) = w; } }
    }
};
struct ProbVT {
    static constexpr bool PERM = false, SWAP = true, GATHER = false;
    const char* A; const char* B; int K, lda, ldb; int G, c; bf16_t* vt;
    __device__ __forceinline__ bool next(int i, Unit& u) const { int pm, pn; if (!static_tile(i, G, c, 64, 4, pm, pn)) return false; u.pm = pm; u.pn = pn < 2 ? 4 + pn : 8 + pn; u.e = -1; u.cnt = 0; return true; }
    __device__ __forceinline__ size_t a_base(const Unit& u) const { return (size_t)(u.pm * 256) * 2048u; }
    __device__ __forceinline__ size_t b_base(const Unit& u) const { return (size_t)(u.pn * 256) * 2048u; }
    __device__ __forceinline__ void epi(const f32x4 (&acc)[2][2][4][2], const Unit& u, int wr, int wc, int fr, int fq) const {
        const int hg0 = (u.pn < 6) ? (u.pn - 4) * 4 : 8 + (u.pn - 10) * 4;
#pragma unroll
        for (int bj = 0; bj < 2; ++bj)
#pragma unroll
            for (int n = 0; n < 2; ++n) { const int cl = bj * 128 + wc * 32 + n * 16 + fr, hg = hg0 + (cl >> 6), d = cl & 63;
#pragma unroll
                for (int ai = 0; ai < 2; ++ai)
#pragma unroll
                    for (int m = 0; m < 4; ++m) { const int row = u.pm * 256 + ai * 128 + wr * 64 + m * 16 + 4 * fq, b = row >> 12, s = row & 4095;
                        const f32x4 v = acc[ai][bj][m][n]; u32x2 w; w.x = cvt_pk_bf16(v[0], v[1]); w.y = cvt_pk_bf16(v[2], v[3]);
                        *(GAS u32x2*)(vt + ((size_t)((b * 16 + hg) * 64 + d)) * SEQ + s) = w; } }
    }
};
struct ProbZ {
    static constexpr bool PERM = false, SWAP = false, GATHER = false;
    const char* A; const char* B; int K, lda, ldb; int G, c; const float* x; const float* ada; float* z;
    __device__ __forceinline__ bool next(int i, Unit& u) const { int pm, pn; if (!static_tile(i, G, c, 64, 4, pm, pn)) return false; u.pm = pm; u.pn = pn; u.e = -1; u.cnt = 0; return true; }
    __device__ __forceinline__ size_t a_base(const Unit& u) const { return (size_t)(u.pm * 256) * 2048u; }
    __device__ __forceinline__ size_t b_base(const Unit& u) const { return (size_t)(u.pn * 256) * 2048u; }
    __device__ __forceinline__ void epi(const f32x4 (&acc)[2][2][4][2], const Unit& u, int wr, int wc, int fr, int fq) const {
        const int b = (u.pm * 256) >> 12; const int col0 = u.pn * 256 + wc * 32 + 4 * fq;
#pragma unroll
        for (int bj = 0; bj < 2; ++bj)
#pragma unroll
            for (int n = 0; n < 2; ++n) { const int col = col0 + bj * 128 + n * 16; const f32x4 gv = *(const GAS f32x4*)(ada + b * 6144 + 2048 + col) + 1.0f;
#pragma unroll
                for (int ai = 0; ai < 2; ++ai)
#pragma unroll
                    for (int m = 0; m < 4; ++m) { const size_t off = (size_t)(u.pm * 256 + ai * 128 + wr * 64 + m * 16 + fr) * DM + col;
                        const f32x4 xv = *(const GAS f32x4*)(x + off); *(GAS f32x4*)(z + off) = xv * ALPHA + gv * acc[ai][bj][m][n]; } }
    }
};
struct ProbP6 {
    static constexpr bool PERM = true, SWAP = false, GATHER = false;
    const char* A; const char* B; int K, lda, ldb; int G, c; float* logits; bf16_t* hs;
    __device__ __forceinline__ bool next(int i, Unit& u) const { const int L = i * G + c; if (L >= 192) return false;
        u.pm = L / 3; u.e = L % 3; u.pn = 0; u.cnt = 0; return true; }
    __device__ __forceinline__ size_t a_base(const Unit& u) const { return (size_t)(u.pm * 256) * 4096u + (u.e == 1 ? 2048u : 0u); }
    __device__ __forceinline__ size_t b_base(const Unit& u) const {
        if (u.e >= 0) return (size_t)(u.e == 2 ? 256 : 0) * 2048u;
        return (size_t)(WS_WSGU - WS_WR) + (size_t)(u.pn * 256) * 2048u; }
    __device__ __forceinline__ void epi(const f32x4 (&acc)[2][2][4][2], const Unit& u, int wr, int wc, int fr, int fq) const {
        if (u.e >= 0) {
            float* out = logits + (size_t)u.e * NTOK * NEXP;
#pragma unroll
            for (int ai = 0; ai < 2; ++ai)
#pragma unroll
                for (int m = 0; m < 4; ++m) { float* rowp = out + (size_t)(u.pm * 256 + ai * 128 + wr * 64 + m * 16 + fr) * NEXP + wc * 32 + 8 * fq;
#pragma unroll
                    for (int bj = 0; bj < 2; ++bj) { *(GAS f32x4*)(rowp + bj * 128) = acc[ai][bj][m][0]; *(GAS f32x4*)(rowp + bj * 128 + 4) = acc[ai][bj][m][1]; } }
        } else {
#pragma unroll
            for (int ai = 0; ai < 2; ++ai)
#pragma unroll
                for (int m = 0; m < 4; ++m) { bf16_t* rowp = hs + (size_t)(u.pm * 256 + ai * 128 + wr * 64 + m * 16 + fr) * DEXP + u.pn * 128 + wc * 32 + 8 * fq;
                    float h[8];
#pragma unroll
                    for (int n = 0; n < 2; ++n)
#pragma unroll
                        for (int q = 0; q < 4; ++q) { const float g = acc[ai][0][m][n][q], up = acc[ai][1][m][n][q]; h[n * 4 + q] = g / (1.f + __expf(-g)) * up; }
                    u32x4 w; w.x = cvt_pk_bf16(h[0], h[1]); w.y = cvt_pk_bf16(h[2], h[3]); w.z = cvt_pk_bf16(h[4], h[5]); w.w = cvt_pk_bf16(h[6], h[7]);
                    *(GAS u32x4*)rowp = w; }
        }
    }
};
struct ExpTab { const LAS int* ts; int NT; const unsigned* cnt; const int* list; };
__device__ __forceinline__ int exp_of_tile(const ExpTab& T, int tile) { int lo = 0, hi = NEXP;
    while (hi - lo > 1) { const int mid = (lo + hi) >> 1; if (T.ts[mid] <= tile) lo = mid; else hi = mid; } return lo; }
struct ProbP8 {
    static constexpr bool PERM = true, SWAP = false, GATHER = true;
    const char* A; const char* B; int K, lda, ldb; int G, c; ExpTab T; bf16_t* hs;
    __device__ __forceinline__ bool next(int i, Unit& u) const { const int L = i * G + c; if (L >= T.NT * 2 + 128) return false; u.pn = L & 1;
        if (L < T.NT * 2) { const int tile = L >> 1; const int e = exp_of_tile(T, tile); u.e = e; u.pm = tile; u.cnt = (int)T.cnt[e] - 256 * (tile - T.ts[e]); }
        else { u.e = -1; u.pm = (L - T.NT * 2) >> 1; u.cnt = 256; } return true; }
    __device__ __forceinline__ size_t a_base(const Unit&) const { return 0; }
    __device__ __forceinline__ unsigned a_row(const Unit& u, int r) const { if (u.e < 0) return (unsigned)(u.pm * 256 + r) * 4096u;
        const int pos = r < u.cnt ? 256 * (u.pm - T.ts[u.e]) + r : 0; const int a = T.list[(size_t)u.e * LIST_CAP + pos]; return (unsigned)(a >> 3) * 4096u; }
    __device__ __forceinline__ size_t b_base(const Unit& u) const { return u.e >= 0 ? (size_t)(WS_WGU - WS_WSGU) + (size_t)(u.e * 512 + u.pn * 256) * 2048u : (size_t)(u.pn * 256) * 2048u; }
    __device__ __forceinline__ void epi(const f32x4 (&acc)[2][2][4][2], const Unit& u, int wr, int wc, int fr, int fq) const {
#pragma unroll
        for (int ai = 0; ai < 2; ++ai)
#pragma unroll
            for (int m = 0; m < 4; ++m) { bf16_t* rowp = (bf16_t*)((unsigned char*)hs + (u.e >= 0 ? (size_t)(WS_H - WS_HS) : (size_t)0)) + (size_t)(u.pm * 256 + ai * 128 + wr * 64 + m * 16 + fr) * DEXP + u.pn * 128 + wc * 32 + 8 * fq;
                float hv[8];
#pragma unroll
                for (int n = 0; n < 2; ++n)
#pragma unroll
                    for (int q = 0; q < 4; ++q) { const float g = acc[ai][0][m][n][q], up = acc[ai][1][m][n][q]; hv[n * 4 + q] = g / (1.f + __expf(-g)) * up; }
                u32x4 w; w.x = cvt_pk_bf16(hv[0], hv[1]); w.y = cvt_pk_bf16(hv[2], hv[3]); w.z = cvt_pk_bf16(hv[4], hv[5]); w.w = cvt_pk_bf16(hv[6], hv[7]);
                *(GAS u32x4*)rowp = w; }
    }
};
struct ProbP9 {
    static constexpr bool PERM = true, SWAP = false, GATHER = false;
    const char* A; const char* B; int K, lda, ldb; int G, c; ExpTab T; const float* topw; bf16_t* y; bf16_t* ys;
    __device__ __forceinline__ bool next(int i, Unit& u) const { const int L = i * G + c; const int NR = T.NT * 4; if (L >= NR + 256) return false;
        if (L < NR) { const int tile = L >> 2; u.pn = L & 3; const int e = exp_of_tile(T, tile); u.e = e; u.pm = tile; u.cnt = (int)T.cnt[e] - 256 * (tile - T.ts[e]); }
        else { const int q = L - NR; u.pm = q >> 2; u.pn = q & 3; u.e = -1; u.cnt = 256; } return true; }
    __device__ __forceinline__ size_t a_base(const Unit& u) const { return (u.e >= 0 ? (size_t)(WS_H - WS_HS) : (size_t)0) + (size_t)(u.pm * 256) * 512u; }
    __device__ __forceinline__ size_t b_base(const Unit& u) const { return u.e >= 0 ? (size_t)(WS_WD - WS_WSD) + (size_t)(u.e * 1024 + u.pn * 256) * 512u : (size_t)(u.pn * 256) * 512u; }
    __device__ __forceinline__ void epi(const f32x4 (&acc)[2][2][4][2], const Unit& u, int wr, int wc, int fr, int fq) const {
        bf16_t* base = (bf16_t*)((unsigned char*)ys + (u.e >= 0 ? (size_t)(WS_Y - WS_YS) : (size_t)0)) + (size_t)(u.pm * 256) * DM + u.pn * 256 + wc * 32 + 8 * fq;
#pragma unroll
        for (int ai = 0; ai < 2; ++ai)
#pragma unroll
            for (int m = 0; m < 4; ++m) { const int r = ai * 128 + wr * 64 + m * 16 + fr;
                if (r < u.cnt) { bf16_t* rowp = base + (size_t)r * DM;
#pragma unroll
                    for (int bj = 0; bj < 2; ++bj) { const f32x4 v0 = acc[ai][bj][m][0], v1 = acc[ai][bj][m][1]; u32x4 o;
                        o.x = cvt_pk_bf16(v0[0], v0[1]); o.y = cvt_pk_bf16(v0[2], v0[3]); o.z = cvt_pk_bf16(v1[0], v1[1]); o.w = cvt_pk_bf16(v1[2], v1[3]);
                        *(GAS u32x4*)(rowp + bj * 128) = o; } } }
    }
};

struct Cvt { const float* wge; const float* wue; const float* wde; bf16_t* wgu; bf16_t* wd; int e, r, pend, pend_e, tick; f32x4 v[8]; };
__device__ __forceinline__ void cvt_retire(Cvt& c, int lane) {
    const int r = c.pend, e = c.pend_e, kg = lane >> 3, n4 = lane & 7;
    bf16_t* dst; size_t rstride;
    if (r < 256) { const int mat = r >> 7, q = r & 127, kb = q >> 3, nb = q & 7, n = 32 * nb + 4 * n4, ct = n >> 7, j = n & 127;
        dst = c.wgu + ((size_t)e * 512 + 256 * ct + 128 * mat + j) * DM + 64 * kb + 8 * kg; rstride = DM; }
    else { const int q = r - 256, kb = q >> 5, nb = q & 31;
        dst = c.wd + ((size_t)e * DM + 32 * nb + 4 * n4) * DEXP + 64 * kb + 8 * kg; rstride = DEXP; }
#pragma unroll
    for (int i = 0; i < 4; ++i) { u32x4 o; o.x = cvt_pk_bf16(c.v[0][i], c.v[1][i]); o.y = cvt_pk_bf16(c.v[2][i], c.v[3][i]); o.z = cvt_pk_bf16(c.v[4][i], c.v[5][i]); o.w = cvt_pk_bf16(c.v[6][i], c.v[7][i]);
        *(GAS u32x4*)(dst + (size_t)i * rstride) = o; }
}
__device__ __forceinline__ void cvt_issue(Cvt& c, int lane) {
    const int r = c.r, kg = lane >> 3, n4 = lane & 7; const float* src; size_t sstride;
    if (r < 256) { const int mat = r >> 7, q = r & 127, kb = q >> 3, nb = q & 7; src = (mat ? c.wue : c.wge) + (size_t)c.e * DM * DEXP + (size_t)(64 * kb + 8 * kg) * DEXP + 32 * nb + 4 * n4; sstride = DEXP; }
    else { const int q = r - 256, kb = q >> 5, nb = q & 31; src = c.wde + (size_t)c.e * DEXP * DM + (size_t)(64 * kb + 8 * kg) * DM + 32 * nb + 4 * n4; sstride = DM; }
#pragma unroll
    for (int kk = 0; kk < 8; ++kk) c.v[kk] = *(const GAS f32x4*)(src + kk * sstride);
}
__device__ __forceinline__ void cvt_tick(Cvt& c, int lane, int G) {
    if (c.pend >= 0) { cvt_retire(c, lane); c.pend = -1; }
    if (c.e < NEXP) { cvt_issue(c, lane); c.pend = c.r; c.pend_e = c.e; c.r += NWAVES; if (c.r >= 384) { c.r -= 384; c.e += G; } }
}

constexpr int AT_TILE = 8192;
constexpr int AT_K = 0, AT_V = 2 * AT_TILE, AT_F = 4 * AT_TILE, AT_BUF = 4 * AT_TILE + 512;
__device__ __forceinline__ int at_sw(int row, int chunk) { return row * 128 + ((chunk ^ (row & 7)) << 4); }

template <int TYPE>
__device__ __forceinline__ void attn_unit(Frame& F, Cvt& cv, int b, int hh, int qb) {
    LAS unsigned char* lds = F.lds;
    const int tid = F.tid, lane = F.lane, w = F.wave, r = lane & 31, hf = lane >> 5;
    const bf16_t* qk = (const bf16_t*)(F.ws + WS_QK); const bf16_t* vt = (const bf16_t*)(F.ws + WS_VT); bf16_t* o = (bf16_t*)(F.ws + WS_O);
    const float* fcum = (const float*)(F.ws + WS_FCUM) + (size_t)(b * 8 + hh) * SEQ;
    const int qcol = (TYPE == 0 ? 0 : 1536) + hh * 64, kcol = (TYPE == 0 ? 512 : 2048) + hh * 64, hg = TYPE * 8 + hh;
    const int q0 = qb * 256, qrow = q0 + 32 * w + r;
    const size_t tok0 = (size_t)b * SEQ;
    bf16x8 qf[4];
#pragma unroll
    for (int s = 0; s < 4; ++s) qf[s] = *(const GAS bf16x8*)(qk + (tok0 + qrow) * NQKV + qcol + 16 * s + 8 * hf);
    const float fq2 = TYPE == 0 ? fcum[qrow] : 0.f;
    const int srow = tid >> 3, sch = tid & 7;
    const bf16_t* kg = qk + (tok0 + srow) * NQKV + kcol + 8 * sch;
    const bf16_t* vg = vt + ((size_t)((b * 16 + hg) * 64 + srow)) * SEQ + 8 * sch;
    const int sdst = at_sw(srow, sch);
    const int ntiles = 4 * (qb + 1), jw = 4 * qb + (w >> 1);
    const int pir = (r & 0x13) | ((r & 4) << 1) | ((r & 8) >> 1);
    bf16x8 tneg[2];
    if (TYPE == 1) {
#pragma unroll
        for (int s2 = 0; s2 < 2; ++s2)
#pragma unroll
            for (int j = 0; j < 8; ++j) tneg[s2][j] = (16 * s2 + 8 * hf + j > pir) ? (short)0xBF80 : (short)0;
    }
    f32x16 oacc[2];
#pragma unroll
    for (int i = 0; i < 16; ++i) { oacc[0][i] = 0.f; oacc[1][i] = 0.f; }
    float mrun = -1e30f, lrun = 0.f, Rrun = 0.f;

    const int jfirst = TYPE == 0 ? 0 : ntiles - 1, jstep = TYPE == 0 ? 1 : -1;
    { const int j = jfirst; const u32x4 kv = *(const GAS u32x4*)(kg + (size_t)64 * j * NQKV), vv = *(const GAS u32x4*)(vg + 64 * j);
      *(LAS u32x4*)(lds + AT_K + sdst) = kv; *(LAS u32x4*)(lds + AT_V + sdst) = vv;
      if (TYPE == 0 && tid < 64) *(LAS float*)(lds + AT_F + tid * 4) = fcum[64 * j + tid]; }
    __syncthreads();
    for (int it = 0; it < ntiles; ++it) {
        const int j = jfirst + it * jstep, cur = it & 1, nb = cur ^ 1;
        const bool more = it + 1 < ntiles;
        u32x4 kvn, vvn; float fn = 0.f;
        cvt_tick(cv, lane, F.G);
        if (more) { const int jn = j + jstep; kvn = *(const GAS u32x4*)(kg + (size_t)64 * jn * NQKV); vvn = *(const GAS u32x4*)(vg + 64 * jn); if (TYPE == 0 && tid < 64) fn = fcum[64 * jn + tid]; }
        if (j <= jw) {
            LAS unsigned char* kt = lds + AT_K + cur * AT_TILE; LAS unsigned char* vtl = lds + AT_V + cur * AT_TILE;
            const bool diag = (j == jw);
#pragma unroll
            for (int kb0 = 0; kb0 < 2; ++kb0) {
                const int kb = TYPE == 0 ? kb0 : 1 - kb0;
                const bool skip = diag && ((w & 1) == 0) && kb == 1;
                if (!skip) {
                    const bool mask = diag && (((w & 1) == 0) ? (kb == 0) : (kb == 1));
                    f32x16 s;
                    if (TYPE == 0) { const LAS float* ftb = (const LAS float*)(lds + AT_F + cur * 256) + 32 * kb + 8 * hf;
                        const f32x4 f0 = *(const LAS f32x4*)(ftb), f1 = *(const LAS f32x4*)(ftb + 4), f2 = *(const LAS f32x4*)(ftb + 16), f3 = *(const LAS f32x4*)(ftb + 20);
#pragma unroll
                        for (int i = 0; i < 4; ++i) { s[i] = fq2 - f0[i]; s[4 + i] = fq2 - f1[i]; s[8 + i] = fq2 - f2[i]; s[12 + i] = fq2 - f3[i]; } }
                    else {
#pragma unroll
                        for (int i = 0; i < 16; ++i) s[i] = 0.f; }
#pragma unroll
                    for (int st = 0; st < 4; ++st) { const bf16x8 kf = *(const LAS bf16x8*)(kt + at_sw(32 * kb + pir, 2 * st + hf)); s = __builtin_amdgcn_mfma_f32_32x32x16_bf16(kf, qf[st], s, 0, 0, 0); }
                    bf16x8 pf[2];
                    if (TYPE == 0) {
                        float mx = -1e30f;
#pragma unroll
                        for (int i = 0; i < 16; ++i) { float v = s[i]; if (mask && (16 * (i >> 3) + 8 * hf + (i & 7) > r)) v = -1e30f; s[i] = v; mx = fmaxf(mx, v); }
                        mx = fmaxf(mx, __shfl_xor(mx, 32));
                        if (__any(mx > mrun + 4.0f)) { const float mn = fmaxf(mrun, mx), al = __builtin_amdgcn_exp2f(mrun - mn); mrun = mn; lrun *= al;
#pragma unroll
                            for (int i = 0; i < 16; ++i) { oacc[0][i] *= al; oacc[1][i] *= al; } }
                        float ps = 0.f;
#pragma unroll
                        for (int i = 0; i < 16; ++i) { const float p = __builtin_amdgcn_exp2f(s[i] - mrun); s[i] = p; ps += p; }
                        lrun += ps;
                    } else {
                        float ls = 0.f; f32x16 cin; unsigned lp[8];
#pragma unroll
                        for (int i = 0; i < 16; ++i) { const float z = s[i]; float L = z > 30.f ? z : __builtin_amdgcn_logf(1.f + __builtin_amdgcn_exp2f(z));
                            const bool valid = !(mask && (16 * (i >> 3) + 8 * hf + (i & 7) >= r));
                            L = valid ? L : 0.f; ls += L; cin[i] = z - L - Rrun; s[i] = L; }
#pragma unroll
                        for (int i = 0; i < 8; ++i) lp[i] = cvt_pk_bf16(s[2 * i], s[2 * i + 1]);
                        bf16x8 lf0, lf1; { u32x4 t0 = {lp[0], lp[1], lp[2], lp[3]}, t1 = {lp[4], lp[5], lp[6], lp[7]}; lf0 = __builtin_bit_cast(bf16x8, t0); lf1 = __builtin_bit_cast(bf16x8, t1); }
#if defined(DBG_VALU_CUM)
                        {
                          float G0 = 0.f, G1 = 0.f;
#pragma unroll
                          for (int i = 0; i < 8; ++i) { G0 += s[i]; G1 += s[8 + i]; }
                          const float PG0 = __shfl_xor(G0, 32), PG1 = __shfl_xor(G1, 32);
                          const float later0 = (hf == 0 ? PG0 : 0.f) + G1 + PG1;
                          const float later1 = (hf == 0 ? PG1 : 0.f);
                          float run = 0.f;
#pragma unroll
                          for (int i = 7; i >= 0; --i) { cin[i] -= run + later0; run += s[i]; }
                          run = 0.f;
#pragma unroll
                          for (int i = 15; i >= 8; --i) { cin[i] -= run + later1; run += s[i]; } }
                        asm volatile("" :: "v"(lf0), "v"(lf1));
#else
                        cin = __builtin_amdgcn_mfma_f32_32x32x16_bf16(tneg[0], lf0, cin, 0, 0, 0);
                        cin = __builtin_amdgcn_mfma_f32_32x32x16_bf16(tneg[1], lf1, cin, 0, 0, 0);
#endif
#pragma unroll
                        for (int i = 0; i < 16; ++i) { const bool valid = !(mask && (16 * (i >> 3) + 8 * hf + (i & 7) >= r)); s[i] = valid ? __builtin_amdgcn_exp2f(cin[i]) : 0.f; }
                        ls += __shfl_xor(ls, 32); Rrun += ls;
                    }
                    { unsigned pp[8];
#pragma unroll
                      for (int i = 0; i < 8; ++i) pp[i] = cvt_pk_bf16(s[2 * i], s[2 * i + 1]);
                      u32x4 t0 = {pp[0], pp[1], pp[2], pp[3]}, t1 = {pp[4], pp[5], pp[6], pp[7]}; pf[0] = __builtin_bit_cast(bf16x8, t0); pf[1] = __builtin_bit_cast(bf16x8, t1); }
#pragma unroll
                    for (int dt = 0; dt < 2; ++dt)
#pragma unroll
                        for (int s2 = 0; s2 < 2; ++s2) { const bf16x8 vf = *(const LAS bf16x8*)(vtl + at_sw(32 * dt + r, 4 * kb + 2 * s2 + hf)); oacc[dt] = __builtin_amdgcn_mfma_f32_32x32x16_bf16(vf, pf[s2], oacc[dt], 0, 0, 0); }
                }
            }
        }
        if (more) { *(LAS u32x4*)(lds + AT_K + nb * AT_TILE + sdst) = kvn; *(LAS u32x4*)(lds + AT_V + nb * AT_TILE + sdst) = vvn; if (TYPE == 0 && tid < 64) *(LAS float*)(lds + AT_F + nb * 256 + tid * 4) = fn; }
        if (TYPE == 1) { const bool done = __all(Rrun > 160.f); if (lane == 0) *(LAS unsigned*)(lds + AT_F + (it & 1) * 32 + w * 4) = done ? 1u : 0u; }
        __syncthreads();
        if (TYPE == 1) { const u32x4 d0 = *(const LAS u32x4*)(lds + AT_F + (it & 1) * 32), d1 = *(const LAS u32x4*)(lds + AT_F + (it & 1) * 32 + 16);
            if ((d0.x & d0.y & d0.z & d0.w & d1.x & d1.y & d1.z & d1.w) != 0u) break; }
    }
    if (TYPE == 1) __syncthreads();
    float inv = 1.f;
    if (TYPE == 0) { const float lt = lrun + __shfl_xor(lrun, 32); inv = 1.f / lt; }
    float ss = 0.f;
#pragma unroll
    for (int dt = 0; dt < 2; ++dt)
#pragma unroll
        for (int i = 0; i < 16; ++i) { const float v = oacc[dt][i] * inv; oacc[dt][i] = v; ss += v * v; }
    ss += __shfl_xor(ss, 32);
    float rs = 1.0f / sqrtf(ss * (1.f / 64.f) + RMS_EPS);
#if defined(DBG_ZERO_SB)
    if (TYPE == 1) rs = 0.f;
#endif
#if defined(DBG_ZERO_FOX)
    if (TYPE == 0) rs = 0.f;
#endif
    const float* g = (TYPE == 0 ? F.in[I_FOXG] : F.in[I_SBG]) + hh * 64;
    bf16_t* orow = o + (tok0 + qrow) * DM + hg * 64;
#pragma unroll
    for (int dt = 0; dt < 2; ++dt)
#pragma unroll
        for (int q = 0; q < 4; ++q) { const int d = 32 * dt + 8 * q + 4 * hf; const f32x4 gv = *(const GAS f32x4*)(g + d);
            u32x2 wv; wv.x = cvt_pk_bf16(oacc[dt][4 * q] * rs * gv[0], oacc[dt][4 * q + 1] * rs * gv[1]); wv.y = cvt_pk_bf16(oacc[dt][4 * q + 2] * rs * gv[2], oacc[dt][4 * q + 3] * rs * gv[3]);
            *(GAS u32x2*)(orow + d) = wv; }
}

__device__ __forceinline__ void phase_attn(Frame& F) {
    frame_refresh(F);
    Cvt cv; cv.wge = F.in[I_WGE]; cv.wue = F.in[I_WUE]; cv.wde = F.in[I_WDE]; cv.wgu = (bf16_t*)(F.ws + WS_WGU); cv.wd = (bf16_t*)(F.ws + WS_WD);
    cv.e = F.bx; cv.r = F.wave; cv.pend = -1; cv.pend_e = 0; cv.tick = 0;
#pragma unroll
    for (int i = 0; i < 8; ++i) cv.v[i] = (f32x4){0.f, 0.f, 0.f, 0.f};
    for (int p = F.vcu; p < 512; p += F.G) {
        const int type = p >> 8, combo = (p & 255) >> 3, qp = p & 7, b = combo >> 3, hh = combo & 7;
        if (type == 0) { attn_unit<0>(F, cv, b, hh, 15 - qp); attn_unit<0>(F, cv, b, hh, qp); }
        else { attn_unit<1>(F, cv, b, hh, 15 - qp); attn_unit<1>(F, cv, b, hh, qp); }
    }
    while (cv.e < NEXP || cv.pend >= 0) cvt_tick(cv, F.lane, F.G);
}

__device__ __forceinline__ void phase5(Frame& F) {
    frame_refresh(F);
    const int gw = F.vcu * NWAVES + F.wave, NGW = F.G * NWAVES;
    float* x1 = (float*)(F.ws + WS_X1); bf16_t* u2 = (bf16_t*)(F.ws + WS_U2); const float* ada = (const float*)(F.ws + WS_ADA);
    const float* g1 = F.in[I_LN1G]; const float* b1 = F.in[I_LN1B];
    for (int m0 = gw; m0 < NTOK; m0 += 2 * NGW) {
        f32x4 v[2][4];
#pragma unroll
        for (int rr = 0; rr < 2; ++rr) { const int m = m0 + rr * NGW;
#pragma unroll
            for (int j = 0; j < 4; ++j) v[rr][j] = (m < NTOK) ? *(const GAS f32x4*)(x1 + (size_t)m * DM + 4 * F.lane + 256 * j) : (f32x4){0.f, 0.f, 0.f, 0.f}; }
        float s[2], s2[2];
#pragma unroll
        for (int rr = 0; rr < 2; ++rr) { s[rr] = 0.f;
#pragma unroll
            for (int j = 0; j < 4; ++j) s[rr] += (v[rr][j][0] + v[rr][j][1]) + (v[rr][j][2] + v[rr][j][3]); }
#pragma unroll
        for (int o = 1; o < 64; o <<= 1) { s[0] += __shfl_xor(s[0], o); s[1] += __shfl_xor(s[1], o); }
#pragma unroll
        for (int rr = 0; rr < 2; ++rr) { const float mean = s[rr] * (1.f / DM); s2[rr] = 0.f;
#pragma unroll
            for (int j = 0; j < 4; ++j) { v[rr][j] = v[rr][j] - mean; s2[rr] += (v[rr][j][0] * v[rr][j][0] + v[rr][j][1] * v[rr][j][1]) + (v[rr][j][2] * v[rr][j][2] + v[rr][j][3] * v[rr][j][3]); } }
#pragma unroll
        for (int o = 1; o < 64; o <<= 1) { s2[0] += __shfl_xor(s2[0], o); s2[1] += __shfl_xor(s2[1], o); }
#pragma unroll
        for (int rr = 0; rr < 2; ++rr) { const int m = m0 + rr * NGW; if (m >= NTOK) break;
            const int b = m >> 12; const float rstd = 1.f / sqrtf(s2[rr] * (1.f / DM) + LN_EPS);
#pragma unroll
            for (int j = 0; j < 4; ++j) { const int d = 4 * F.lane + 256 * j;
                const f32x4 gg = *(const GAS f32x4*)(g1 + d), bb = *(const GAS f32x4*)(b1 + d);
                const f32x4 xo = v[rr][j] * rstd * gg + bb; *(GAS f32x4*)(x1 + (size_t)m * DM + d) = xo;
                const f32x4 sc = *(const GAS f32x4*)(ada + b * 6144 + 4096 + d) + 1.0f, sh = *(const GAS f32x4*)(ada + b * 6144 + 3072 + d);
                const f32x4 u = xo * sc + sh;
                unsigned hb[4]; float lo[4];
#pragma unroll
                for (int q = 0; q < 4; ++q) { hb[q] = f2bf(u[q]); lo[q] = u[q] - bf2f(hb[q]); }
                u32x2 wh, wl; wh.x = hb[0] | (hb[1] << 16); wh.y = hb[2] | (hb[3] << 16); wl.x = pk2(lo[0], lo[1]); wl.y = pk2(lo[2], lo[3]);
                *(GAS u32x2*)(u2 + (size_t)m * 2048 + d) = wh; *(GAS u32x2*)(u2 + (size_t)m * 2048 + 1024 + d) = wl; } }
    }
}

__device__ __forceinline__ void phase7(Frame& F) {
    frame_refresh(F);
    const int gw = F.vcu * NWAVES + F.wave, NGW = F.G * NWAVES, lane = F.lane;
    const float* lg = (const float*)(F.ws + WS_LOG); const float* rb = F.in[I_RB];
    unsigned* cnt = (unsigned*)(F.ws + WS_CTL) + CW_CNT; int* list = (int*)(F.ws + WS_LIST); float* topw = (float*)(F.ws + WS_TOPW); int* apos = (int*)(F.ws + WS_APOS);
    const f32x4 bias = *(const GAS f32x4*)(rb + 4 * lane);
    for (int t = gw; t < NTOK; t += NGW) {
        const size_t off = (size_t)t * NEXP + 4 * lane;
        const f32x4 l0 = *(const GAS f32x4*)(lg + off), l1 = *(const GAS f32x4*)(lg + (size_t)NTOK * NEXP + off), l2 = *(const GAS f32x4*)(lg + 2 * (size_t)NTOK * NEXP + off);
        float sc[4], sel[4];
#pragma unroll
        for (int i = 0; i < 4; ++i) { const float z = (l0[i] + l1[i]) + l2[i]; sc[i] = 1.f / (1.f + expf(-z)); sel[i] = sc[i] + bias[i]; }
        float a1 = fmaxf(sel[0], sel[1]), a2 = fminf(sel[0], sel[1]);
        { const float c1 = fmaxf(sel[2], sel[3]), c2 = fminf(sel[2], sel[3]); const float n1 = fmaxf(a1, c1), n2 = fmaxf(fminf(a1, c1), fmaxf(a2, c2)); a1 = n1; a2 = n2; }
#pragma unroll
        for (int o = 1; o < 8; o <<= 1) { const float b1v = __shfl_xor(a1, o), b2v = __shfl_xor(a2, o); const float n1 = fmaxf(a1, b1v), n2 = fmaxf(fminf(a1, b1v), fmaxf(a2, b2v)); a1 = n1; a2 = n2; }
        const float gs = a1 + a2; const int g = lane >> 3; int rank = 0;
#pragma unroll
        for (int gg = 0; gg < 8; ++gg) { const float o = __shfl(gs, gg * 8); rank += (o > gs || (o == gs && gg < g)) ? 1 : 0; }
        const bool gsel = rank < 4;
        float cand[4];
#pragma unroll
        for (int i = 0; i < 4; ++i) cand[i] = gsel ? sel[i] : -INFINITY;
        int my_e = 0; float my_w = 0.f, wsum = 0.f;
#pragma unroll
        for (int k = 0; k < TOPK; ++k) {
            float bv = cand[0]; int bi = 4 * lane;
#pragma unroll
            for (int i = 1; i < 4; ++i) if (cand[i] > bv) { bv = cand[i]; bi = 4 * lane + i; }
#pragma unroll
            for (int o = 32; o >= 1; o >>= 1) { const float ov = __shfl_xor(bv, o); const int oi = __shfl_xor(bi, o); if (ov > bv || (ov == bv && oi < bi)) { bv = ov; bi = oi; } }
            const int wl = bi >> 2, wi = bi & 3;
            float scw = sc[0]; scw = wi == 1 ? sc[1] : scw; scw = wi == 2 ? sc[2] : scw; scw = wi == 3 ? sc[3] : scw;
            scw = __shfl(scw, wl);
            if (lane == wl) {
#pragma unroll
                for (int i = 0; i < 4; ++i) if (i == wi) cand[i] = -INFINITY; }
            wsum += scw;
            if (lane == k) { my_e = bi; my_w = scw; }
        }
        if (lane < TOPK) { const int a = t * TOPK + lane; topw[a] = my_w / wsum * ROUTED_SCALE;
            const unsigned pos = atomicAdd(&cnt[my_e], 1u); list[(size_t)my_e * LIST_CAP + pos] = a; apos[a] = (my_e << 16) | (int)pos; }
    }
}

__device__ __forceinline__ int build_tile_table(Frame& F) {
    LAS int* ts = (LAS int*)(F.lds + TS_OFF); const unsigned* cnt = (const unsigned*)(F.ws + WS_CTL) + CW_CNT;
    __syncthreads();
    if (F.tid == 0) { int a = 0; for (int e = 0; e < NEXP; ++e) { ts[e] = a; a += ((int)__hip_atomic_load(cnt + e, RLX_AGENT) + 255) >> 8; } ts[NEXP] = a; }
    __syncthreads();
    return ts[NEXP];
}

__device__ __forceinline__ void phase10(Frame& F) {
    frame_refresh(F);
    const int gw = F.vcu * NWAVES + F.wave, NGW = F.G * NWAVES;
    const float* x1 = (const float*)(F.ws + WS_X1); const bf16_t* y = (const bf16_t*)(F.ws + WS_Y); const bf16_t* ys = (const bf16_t*)(F.ws + WS_YS); const float* ada = (const float*)(F.ws + WS_ADA);
    const int* apos = (const int*)(F.ws + WS_APOS); const float* topw = (const float*)(F.ws + WS_TOPW); const LAS int* ts = (const LAS int*)(F.lds + TS_OFF);
    const float* g2 = F.in[I_LN2G]; const float* b2 = F.in[I_LN2B];
    int apn[TOPK]; float wkn[TOPK];
#pragma unroll
    for (int k = 0; k < TOPK; ++k) { apn[k] = gw < NTOK ? apos[gw * TOPK + k] : 0; wkn[k] = gw < NTOK ? topw[gw * TOPK + k] : 0.f; }
    for (int m = gw; m < NTOK; m += NGW) {
        const int b = m >> 12;
        size_t yrow[TOPK]; float wk[TOPK];
#pragma unroll
        for (int k = 0; k < TOPK; ++k) { const int ap = apn[k]; wk[k] = wkn[k]; yrow[k] = (size_t)(256 * ts[ap >> 16] + (ap & 0xffff)) * DM; }
        u32x2 yv[4][TOPK], sv[4]; f32x4 xv[4];
#pragma unroll
        for (int j = 0; j < 4; ++j) { const int d = 4 * F.lane + 256 * j;
#pragma unroll
            for (int k = 0; k < TOPK; ++k) yv[j][k] = *(const GAS u32x2*)(y + yrow[k] + d);
            sv[j] = *(const GAS u32x2*)(ys + (size_t)m * DM + d); xv[j] = *(const GAS f32x4*)(x1 + (size_t)m * DM + d); }
        { const int mn = m + NGW;
#pragma unroll
          for (int k = 0; k < TOPK; ++k) { apn[k] = mn < NTOK ? apos[mn * TOPK + k] : 0; wkn[k] = mn < NTOK ? topw[mn * TOPK + k] : 0.f; } }
        f32x4 v[4]; float s = 0.f;
#pragma unroll
        for (int j = 0; j < 4; ++j) { const int d = 4 * F.lane + 256 * j;
            f32x4 f = {bf2f(sv[j].x & 0xffffu), bf2f(sv[j].x >> 16), bf2f(sv[j].y & 0xffffu), bf2f(sv[j].y >> 16)};
#pragma unroll
            for (int k = 0; k < TOPK; ++k) { f[0] += wk[k] * bf2f(yv[j][k].x & 0xffffu); f[1] += wk[k] * bf2f(yv[j][k].x >> 16); f[2] += wk[k] * bf2f(yv[j][k].y & 0xffffu); f[3] += wk[k] * bf2f(yv[j][k].y >> 16); }
            const f32x4 gv = *(const GAS f32x4*)(ada + b * 6144 + 5120 + d) + 1.0f;
            v[j] = xv[j] * ALPHA + gv * f; s += (v[j][0] + v[j][1]) + (v[j][2] + v[j][3]); }
        const float mean = wave_sum(s) * (1.f / DM); float s2 = 0.f;
#pragma unroll
        for (int j = 0; j < 4; ++j) { v[j] = v[j] - mean; s2 += (v[j][0] * v[j][0] + v[j][1] * v[j][1]) + (v[j][2] * v[j][2] + v[j][3] * v[j][3]); }
        const float rstd = 1.f / sqrtf(wave_sum(s2) * (1.f / DM) + LN_EPS);
#pragma unroll
        for (int j = 0; j < 4; ++j) { const int d = 4 * F.lane + 256 * j; const f32x4 gg = *(const GAS f32x4*)(g2 + d), bb = *(const GAS f32x4*)(b2 + d);
            *(GAS f32x4*)(F.out + (size_t)m * DM + d) = v[j] * rstd * gg + bb; }
    }
}

__global__ void __launch_bounds__(NTHR, 2) fwd_kernel(Args args) {
    extern __shared__ __attribute__((aligned(16))) unsigned char lds_raw[];
    Frame F;
    F.lds = (LAS unsigned char*)lds_raw; F.ws = args.ws; F.in = args.in; F.out = args.out;
    F.tid = threadIdx.x; F.lane = F.tid & 63; F.wave = __builtin_amdgcn_readfirstlane(F.tid >> 6);
    F.G = gridDim.x; F.bx = blockIdx.x; F.vcu = (F.G % 8 == 0) ? (F.bx % 8) * (F.G / 8) + F.bx / 8 : F.bx;
    volatile LAS unsigned* MISC = (volatile LAS unsigned*)(F.lds + LDSCTL_OFF);
    for (int u = F.tid; u < 64; u += NTHR) MISC[u] = 0u;
    __syncthreads();
    unsigned* ctl = (unsigned*)(F.ws + WS_CTL);
    XcdBarrier bar = xcd_barrier_post(ctl + CW_BAR, MISC + 8);
    unsigned char* ws = F.ws;

    phase0(F);
    xcd_barrier(bar);
#if defined(DUP_P0)
    phase0(F);
    xcd_barrier(bar);
#endif
    phase1(F);
    xcd_barrier(bar);
#if defined(DUP_P1)
    phase1(F);
    xcd_barrier(bar);
#endif
    if (F.bx < 32) fcum_block(F, F.bx);
    __syncthreads();
    { ProbQK p; p.A = (const char*)(ws + WS_U1); p.B = (const char*)(ws + WS_WIN); p.K = DM; p.lda = 2048; p.ldb = 2048; p.G = F.G; p.c = F.bx; p.qk = (bf16_t*)(ws + WS_QK); pg8::gemm_phase(F.lds, p); }
    { ProbVT p; p.A = (const char*)(ws + WS_U1); p.B = (const char*)(ws + WS_WIN); p.K = DM; p.lda = 2048; p.ldb = 2048; p.G = F.G; p.c = F.bx; p.vt = (bf16_t*)(ws + WS_VT); pg8::gemm_phase(F.lds, p); }
    xcd_barrier(bar);
#if defined(DUP_P2)
    { ProbQK p; p.A = (const char*)(ws + WS_U1); p.B = (const char*)(ws + WS_WIN); p.K = DM; p.lda = 2048; p.ldb = 2048; p.G = F.G; p.c = F.bx; p.qk = (bf16_t*)(ws + WS_QK); pg8::gemm_phase(F.lds, p); }
    { ProbVT p; p.A = (const char*)(ws + WS_U1); p.B = (const char*)(ws + WS_WIN); p.K = DM; p.lda = 2048; p.ldb = 2048; p.G = F.G; p.c = F.bx; p.vt = (bf16_t*)(ws + WS_VT); pg8::gemm_phase(F.lds, p); }
    xcd_barrier(bar);
#endif
    phase_attn(F);
    xcd_barrier(bar);
#if defined(DUP_P3)
    phase_attn(F);
    xcd_barrier(bar);
#endif
    { ProbZ p; p.A = (const char*)(ws + WS_O); p.B = (const char*)(ws + WS_WOUT); p.K = DM; p.lda = 2048; p.ldb = 2048; p.G = F.G; p.c = F.bx; p.x = F.in[I_X]; p.ada = (const float*)(ws + WS_ADA); p.z = (float*)(ws + WS_X1); pg8::gemm_phase(F.lds, p); }
    xcd_barrier(bar);
#if defined(DUP_P4)
    { ProbZ p; p.A = (const char*)(ws + WS_O); p.B = (const char*)(ws + WS_WOUT); p.K = DM; p.lda = 2048; p.ldb = 2048; p.G = F.G; p.c = F.bx; p.x = F.in[I_X]; p.ada = (const float*)(ws + WS_ADA); p.z = (float*)(ws + WS_X1); pg8::gemm_phase(F.lds, p); }
    xcd_barrier(bar);
#endif
    phase5(F);
    xcd_barrier(bar);
#if defined(DBG_STOP5)
    { const f32x4* src = (const f32x4*)(ws + WS_X1); f32x4* dst = (f32x4*)F.out;
      for (size_t i = (size_t)F.bx * NTHR + F.tid; i < (size_t)NTOK * DM / 4; i += (size_t)F.G * NTHR) dst[i] = src[i]; }
    return;
#endif
    { ProbP6 p; p.A = (const char*)(ws + WS_U2); p.B = (const char*)(ws + WS_WR); p.K = DM; p.lda = 4096; p.ldb = 2048; p.G = F.G; p.c = F.vcu; p.logits = (float*)(ws + WS_LOG); p.hs = (bf16_t*)(ws + WS_HS); pg8::gemm_phase(F.lds, p); }
    xcd_barrier(bar);
#if defined(DUP_P6)
    { ProbP6 p; p.A = (const char*)(ws + WS_U2); p.B = (const char*)(ws + WS_WR); p.K = DM; p.lda = 4096; p.ldb = 2048; p.G = F.G; p.c = F.vcu; p.logits = (float*)(ws + WS_LOG); p.hs = (bf16_t*)(ws + WS_HS); pg8::gemm_phase(F.lds, p); }
    xcd_barrier(bar);
#endif
    phase7(F);
    xcd_barrier(bar);
    const int NT = build_tile_table(F);
    ExpTab T; T.ts = (const LAS int*)(F.lds + TS_OFF); T.NT = NT; T.cnt = (const unsigned*)(ws + WS_CTL) + CW_CNT; T.list = (const int*)(ws + WS_LIST);
    { ProbP8 p; p.A = (const char*)(ws + WS_U2); p.B = (const char*)(ws + WS_WSGU); p.K = DM; p.lda = 4096; p.ldb = 2048; p.G = F.G; p.c = F.vcu; p.T = T; p.hs = (bf16_t*)(ws + WS_HS); pg8::gemm_phase(F.lds, p); }
    xcd_barrier(bar);
#if defined(DUP_P8)
    { ProbP8 p; p.A = (const char*)(ws + WS_U2); p.B = (const char*)(ws + WS_WSGU); p.K = DM; p.lda = 4096; p.ldb = 2048; p.G = F.G; p.c = F.vcu; p.T = T; p.hs = (bf16_t*)(ws + WS_HS); pg8::gemm_phase(F.lds, p); }
    xcd_barrier(bar);
#endif
    { ProbP9 p; p.A = (const char*)(ws + WS_HS); p.B = (const char*)(ws + WS_WSD); p.K = DEXP; p.lda = 512; p.ldb = 512; p.G = F.G; p.c = F.vcu; p.T = T; p.topw = (const float*)(ws + WS_TOPW); p.y = (bf16_t*)(ws + WS_Y); p.ys = (bf16_t*)(ws + WS_YS); pg8::gemm_phase(F.lds, p); }
    xcd_barrier(bar);
#if defined(DUP_P9)
    { ProbP9 p; p.A = (const char*)(ws + WS_HS); p.B = (const char*)(ws + WS_WSD); p.K = DEXP; p.lda = 512; p.ldb = 512; p.G = F.G; p.c = F.vcu; p.T = T; p.topw = (const float*)(ws + WS_TOPW); p.y = (bf16_t*)(ws + WS_Y); p.ys = (bf16_t*)(ws + WS_YS); pg8::gemm_phase(F.lds, p); }
    xcd_barrier(bar);
#endif
#if defined(DUP_BAR)
    xcd_barrier(bar); xcd_barrier(bar); xcd_barrier(bar); xcd_barrier(bar); xcd_barrier(bar);
#endif
    phase10(F);
#if defined(DUP_P10)
    xcd_barrier(bar);
    phase10(F);
#endif
}

extern "C" void kernel_launch(void* const* d_in, const int* in_sizes, int n_in, void* d_out, int out_size, void* d_ws, size_t ws_size, hipStream_t stream) {
    static int grid = 0;
    if (grid == 0) {
        if (n_in != 21 || out_size != NTOK * DM || ws_size < WS_END) { fprintf(stderr, "kernel_launch: unexpected shapes (n_in %d out %d ws %zu)\n", n_in, out_size, ws_size); grid = -1; return; }
        int dev = 0, cus = 0, per_cu = 0;
        hipGetDevice(&dev); hipDeviceGetAttribute(&cus, hipDeviceAttributeMultiprocessorCount, dev);
        hipFuncSetAttribute((const void*)fwd_kernel, hipFuncAttributeMaxDynamicSharedMemorySize, LDS_BYTES);
        hipOccupancyMaxActiveBlocksPerMultiprocessor(&per_cu, (const void*)fwd_kernel, NTHR, LDS_BYTES);
        (void)hipGetLastError();
        if (per_cu < 1) { fprintf(stderr, "kernel_launch: occupancy query says %d blocks/CU\n", per_cu); }
        grid = cus < 256 ? cus : 256;
        grid -= grid % 8;
    }
    if (grid <= 0) return;
    hipMemsetAsync((char*)d_ws + WS_CTL, 0, CTL_ZERO_BYTES, stream);
    Args a{};
    for (int i = 0; i < 21; ++i) a.in[i] = (const float*)d_in[i];
    a.out = (float*)d_out; a.ws = (unsigned char*)d_ws;
    void* kargs[] = {&a};
    hipError_t e = hipLaunchCooperativeKernel((const void*)fwd_kernel, dim3(grid), dim3(NTHR), kargs, LDS_BYTES, stream);
    if (e != hipSuccess) fprintf(stderr, "kernel_launch: cooperative launch failed: %s (grid %d)\n", hipGetErrorString(e), grid);
}
```
